# Optimizing an MI355X kernel written in HIP

```python
import math
import jax, jax.numpy as jnp
from jax import lax
import numpy as np

D_MODEL = 1024
BATCH = 32
SEQ = 2048
DEPTH = 2

DA_HEADS = 8
DA_HEAD_DIM = 64
DA_WIDTH = DA_HEADS * 2 * DA_HEAD_DIM
NA_HEADS = 16
NA_HEAD_DIM = 32
NA_WIDTH = NA_HEADS * NA_HEAD_DIM
GRID_W = 64
WIN_R = 8
WIN_C = 16
COL_BLOCK = WIN_C
HALO = 2 * WIN_C
Q_BLOCK = 128
N_EXPERTS = 256
TOP_K = 8
N_GROUPS = 8
TOPK_GROUPS = 4
EXPERT_DIM = 256
ROUTE_SCALE = 2.5
MOE_BLOCK = 128
ALPHA = (2 * DEPTH) ** 0.25
BETA = (8 * DEPTH) ** -0.25
LN_EPS = 1e-5
F32 = jnp.float32
IN_SIZES = (DA_WIDTH, DA_WIDTH, DA_WIDTH, NA_WIDTH, NA_WIDTH, NA_WIDTH, D_MODEL, D_MODEL)
IN_COLS = sum(IN_SIZES)

kernel_name = 'hybrid_diffattn_natten_moe_deepnorm'


def _layer_norm(x, g, b):
    xf = x.astype(F32)
    mu = xf.mean(-1, keepdims=True)
    var = jnp.square(xf - mu).mean(-1, keepdims=True)
    return ((xf - mu) * lax.rsqrt(var + LN_EPS) * g.astype(F32) + b.astype(F32)).astype(x.dtype)


def _rms_norm(x, g):
    xf = x.astype(F32)
    y = xf * lax.rsqrt(jnp.mean(jnp.square(xf), -1, keepdims=True) + LN_EPS)
    return (y * g.astype(F32)).astype(x.dtype)


def _alibi_slopes(n):
    return jnp.asarray(2.0 ** (-8.0 * np.arange(1, n + 1) / n), F32)


def _diff_attention(q, k, v, lam, subln_g, lam_init):
    B, S = q.shape[:2]
    nqb = S // Q_BLOCK
    slopes = _alibi_slopes(DA_HEADS)
    kpos = jnp.arange(S, dtype=F32)
    q_blocks = q.reshape(B, nqb, Q_BLOCK, DA_HEADS, 2, DA_HEAD_DIM).transpose(1, 0, 2, 3, 4, 5)

    def block(args):
        q_blk, i = args
        s = jnp.einsum('bqhpd,bkhpd->bhpqk', q_blk, k, preferred_element_type=F32)
        qpos = (i * Q_BLOCK + jnp.arange(Q_BLOCK)).astype(F32)
        dist = jnp.abs(qpos[:, None] - kpos[None, :])
        s = s - slopes[:, None, None, None] * dist
        a = jax.nn.softmax(s, axis=-1)
        w = a[:, :, 0] - lam * a[:, :, 1]
        return jnp.einsum('bhqk,bkhe->bqhe', w.astype(v.dtype), v)

    o = lax.map(block, (q_blocks, jnp.arange(nqb)))
    o = o.transpose(1, 0, 2, 3, 4).reshape(B, S, DA_HEADS, 2 * DA_HEAD_DIM)
    o = _rms_norm(o, subln_g) * (1.0 - lam_init)
    return o.reshape(B, S, DA_WIDTH)


def _na_tables():
    ncb = GRID_W // COL_BLOCK
    col_start = np.clip(np.arange(GRID_W) - WIN_C // 2, 0, GRID_W - WIN_C)
    halo_start = np.clip(np.arange(ncb) * COL_BLOCK - WIN_C // 2, 0, GRID_W - HALO)
    halo_cols = halo_start[:, None] + np.arange(HALO)[None, :]
    qcol = np.arange(ncb)[:, None] * COL_BLOCK + np.arange(COL_BLOCK)[None, :]
    kcol = halo_cols[:, None, :]
    cs = col_start[qcol][:, :, None]
    col_mask = (kcol >= cs) & (kcol < cs + WIN_C)
    col_off = np.clip(kcol - qcol[:, :, None] + WIN_C - 1, 0, 2 * WIN_C - 2)
    return halo_cols, col_mask, col_off


def _neighbourhood_attention(q, k, v, rpb):
    B, S = q.shape[:2]
    rows = S // GRID_W
    kh = min(WIN_R, rows)
    ncb = GRID_W // COL_BLOCK
    halo_cols, col_mask, col_off = _na_tables()

    def to_grid(t):
        return t.reshape(B, rows, GRID_W, NA_HEADS, NA_HEAD_DIM).transpose(0, 3, 1, 2, 4)

    qg, kg, vg = to_grid(q), to_grid(k), to_grid(v)
    q_rows = qg.transpose(2, 0, 1, 3, 4).reshape(rows, B, NA_HEADS, ncb, COL_BLOCK, NA_HEAD_DIM)
    col_bias = rpb[:, :, col_off]
    col_mask_b = jnp.asarray(col_mask)[:, :, None, :]

    def row(args):
        q_r, r = args
        rs = jnp.clip(r - WIN_R // 2, 0, rows - kh)
        k_r = lax.dynamic_slice_in_dim(kg, rs, kh, axis=2)[:, :, :, halo_cols]
        v_r = lax.dynamic_slice_in_dim(vg, rs, kh, axis=2)[:, :, :, halo_cols]
        row_idx = rs + jnp.arange(kh) - r + WIN_R - 1
        bias = col_bias[:, row_idx].transpose(0, 2, 3, 1, 4)
        s = jnp.einsum('bhjqd,bhrjkd->bhjqrk', q_r, k_r, preferred_element_type=F32) + bias
        s = jnp.where(col_mask_b, s, -jnp.inf)
        p = jax.nn.softmax(s, axis=(-2, -1))
        o = jnp.einsum('bhjqrk,bhrjke->bhjqe', p.astype(v.dtype), v_r)
        return o.reshape(B, NA_HEADS, GRID_W, NA_HEAD_DIM)

    o = lax.map(row, (q_rows, jnp.arange(rows)))
    return o.transpose(1, 0, 3, 2, 4).reshape(B, S, NA_WIDTH)


def _mixer(x, w_in, b_gate, lam_q1, lam_k1, lam_q2, lam_k2, subln_g, w_proj_a, rpb, w_proj_b, w_out, lam_init):
    B, S, _ = x.shape
    split_pts = [int(c) for c in np.cumsum(IN_SIZES)[:-1]]
    qa, ka, va, qn, kn, vn, ga, gb = jnp.split(x @ w_in, split_pts, axis=-1)
    qa = qa.reshape(B, S, DA_HEADS, 2, DA_HEAD_DIM) * (DA_HEAD_DIM ** -0.5)
    ka = ka.reshape(B, S, DA_HEADS, 2, DA_HEAD_DIM)
    va = va.reshape(B, S, DA_HEADS, 2 * DA_HEAD_DIM)
    lam = (jnp.exp(jnp.sum(lam_q1.astype(F32) * lam_k1.astype(F32)))
           - jnp.exp(jnp.sum(lam_q2.astype(F32) * lam_k2.astype(F32))) + lam_init)
    y_a = _diff_attention(qa, ka, va, lam, subln_g, lam_init) @ w_proj_a
    y_b = _neighbourhood_attention(qn * (NA_HEAD_DIM ** -0.5), kn, vn, rpb) @ w_proj_b
    g_a = jax.nn.sigmoid(ga + b_gate[0])
    g_b = jax.nn.sigmoid(gb + b_gate[1])
    return (g_a * y_a + g_b * y_b) @ w_out


def _moe(x, router_w, router_bias, wg, wu, wd, swg, swu, swd):
    B, S, D = x.shape
    T = B * S
    xt = x.reshape(T, D)
    scores = jax.nn.sigmoid((xt @ router_w).astype(F32))
    biased = scores + router_bias.astype(F32)
    per_group = N_EXPERTS // N_GROUPS
    grp = lax.top_k(biased.reshape(T, N_GROUPS, per_group), 2)[0].sum(-1)
    _, gsel = lax.top_k(grp, TOPK_GROUPS)
    gmask = jax.nn.one_hot(gsel, N_GROUPS, dtype=F32).sum(-2) > 0
    emask = jnp.repeat(gmask, per_group, axis=-1)
    _, eidx = lax.top_k(jnp.where(emask, biased, -jnp.inf), TOP_K)
    gate = jnp.take_along_axis(scores, eidx, axis=-1)
    gate = gate / gate.sum(-1, keepdims=True) * ROUTE_SCALE
    M = T * TOP_K
    flat_e = eidx.reshape(M)
    flat_t = jnp.repeat(jnp.arange(T, dtype=jnp.int32), TOP_K)
    flat_w = gate.reshape(M)
    order = jnp.argsort(flat_e)
    se, st, sw = flat_e[order], flat_t[order], flat_w[order]
    counts = jnp.bincount(flat_e, length=N_EXPERTS)
    padded = (counts + MOE_BLOCK - 1) // MOE_BLOCK * MOE_BLOCK
    pad_end = jnp.cumsum(padded)
    pad_start = pad_end - padded
    start = jnp.cumsum(counts) - counts
    slot = pad_start[se] + jnp.arange(M) - start[se]
    nb = -(-(M + N_EXPERTS * (MOE_BLOCK - 1)) // MOE_BLOCK)
    n_slots = nb * MOE_BLOCK
    slot_tok = jnp.zeros((n_slots,), jnp.int32).at[slot].set(st)
    slot_w = jnp.zeros((n_slots,), F32).at[slot].set(sw)
    blk_exp = jnp.minimum(jnp.searchsorted(pad_end, jnp.arange(nb) * MOE_BLOCK, side='right'), N_EXPERTS - 1)

    def step(acc, inp):
        tok, w, e = inp
        xb = xt[tok]
        h = jax.nn.silu(xb @ wg[e]) * (xb @ wu[e])
        return acc.at[tok].add((h @ wd[e]) * w[:, None].astype(x.dtype)), None

    routed, _ = lax.scan(step, jnp.zeros_like(xt),
                         (slot_tok.reshape(nb, MOE_BLOCK), slot_w.reshape(nb, MOE_BLOCK), blk_exp))
    shared = (jax.nn.silu(xt @ swg) * (xt @ swu)) @ swd
    return (routed + shared).reshape(B, S, D)


def setup_inputs(seed: int = 0) -> dict:
    key = jax.random.key(seed)
    ks = jax.random.split(key, 32)
    L, D = DEPTH, D_MODEL

    def nrm(k, shape, scale):
        return jax.random.normal(k, shape, F32) * scale

    off = np.concatenate([[0], np.cumsum(IN_SIZES)])
    col_scale = np.ones((IN_COLS,), np.float32)
    col_scale[off[2]:off[3]] = BETA
    col_scale[off[5]:off[6]] = BETA
    return {
        'x': nrm(ks[0], (BATCH, SEQ, D), 1.0),
        'emb_ln_g': 1.0 + nrm(ks[1], (D,), 0.02),
        'emb_ln_b': nrm(ks[2], (D,), 0.02),
        'w_in': nrm(ks[3], (L, D, IN_COLS), D ** -0.5) * jnp.asarray(col_scale),
        'b_gate': nrm(ks[4], (L, 2, D), 0.01),
        'lam_q1': nrm(ks[5], (L, DA_HEAD_DIM), 0.1),
        'lam_k1': nrm(ks[6], (L, DA_HEAD_DIM), 0.1),
        'lam_q2': nrm(ks[7], (L, DA_HEAD_DIM), 0.1),
        'lam_k2': nrm(ks[8], (L, DA_HEAD_DIM), 0.1),
        'subln_g': 1.0 + nrm(ks[9], (L, 2 * DA_HEAD_DIM), 0.02),
        'w_proj_a': nrm(ks[10], (L, DA_WIDTH, D), BETA * DA_WIDTH ** -0.5),
        'na_rpb': nrm(ks[11], (L, NA_HEADS, 2 * WIN_R - 1, 2 * WIN_C - 1), 0.1),
        'w_proj_b': nrm(ks[12], (L, NA_WIDTH, D), BETA * NA_WIDTH ** -0.5),
        'w_out': nrm(ks[13], (L, D, D), BETA * D ** -0.5),
        'ln1_g': 1.0 + nrm(ks[14], (L, D), 0.02),
        'ln1_b': nrm(ks[15], (L, D), 0.02),
        'router_w': nrm(ks[16], (L, D, N_EXPERTS), D ** -0.5),
        'router_bias': nrm(ks[17], (L, N_EXPERTS), 0.01),
        'exp_w_gate': nrm(ks[18], (L, N_EXPERTS, D, EXPERT_DIM), D ** -0.5),
        'exp_w_up': nrm(ks[19], (L, N_EXPERTS, D, EXPERT_DIM), D ** -0.5),
        'exp_w_down': nrm(ks[20], (L, N_EXPERTS, EXPERT_DIM, D), BETA * EXPERT_DIM ** -0.5),
        'sh_w_gate': nrm(ks[21], (L, D, EXPERT_DIM), D ** -0.5),
        'sh_w_up': nrm(ks[22], (L, D, EXPERT_DIM), D ** -0.5),
        'sh_w_down': nrm(ks[23], (L, EXPERT_DIM, D), BETA * EXPERT_DIM ** -0.5),
        'ln2_g': 1.0 + nrm(ks[24], (L, D), 0.02),
        'ln2_b': nrm(ks[25], (L, D), 0.02),
    }


def reference(x, emb_ln_g, emb_ln_b, w_in, b_gate, lam_q1, lam_k1, lam_q2, lam_k2, subln_g, w_proj_a, na_rpb,
              w_proj_b, w_out, ln1_g, ln1_b, router_w, router_bias, exp_w_gate, exp_w_up, exp_w_down,
              sh_w_gate, sh_w_up, sh_w_down, ln2_g, ln2_b):
    h = _layer_norm(x, emb_ln_g, emb_ln_b)
    for l in range(DEPTH):
        lam_init = 0.8 - 0.6 * math.exp(-0.3 * l)
        m = _mixer(h, w_in[l], b_gate[l], lam_q1[l], lam_k1[l], lam_q2[l], lam_k2[l], subln_g[l],
                   w_proj_a[l], na_rpb[l], w_proj_b[l], w_out[l], lam_init)
        h = _layer_norm(ALPHA * h + m, ln1_g[l], ln1_b[l])
        f = _moe(h, router_w[l], router_bias[l], exp_w_gate[l], exp_w_up[l], exp_w_down[l],
                 sh_w_gate[l], sh_w_up[l], sh_w_down[l])
        h = _layer_norm(ALPHA * h + f, ln2_g[l], ln2_b[l])
    return h
```

```cpp
#include <hip/hip_runtime.h>
#include <cstdio>
#include <cstdint>

#ifndef MK_ONE_LAUNCH
#define MK_ONE_LAUNCH 1
#endif

#define LAS __attribute__((address_space(3)))
#define GAS __attribute__((address_space(1)))
typedef unsigned short bf16_t;
typedef short bf16x8 __attribute__((ext_vector_type(8)));
typedef short s16x4 __attribute__((ext_vector_type(4)));
typedef float f32x4 __attribute__((ext_vector_type(4)));
typedef float f32x2 __attribute__((ext_vector_type(2)));
typedef float f32x16 __attribute__((ext_vector_type(16)));
typedef unsigned u32x4 __attribute__((ext_vector_type(4)));
typedef unsigned u32x2 __attribute__((ext_vector_type(2)));

constexpr int BATCH = 32, SEQ = 2048, DM = 1024, T = BATCH * SEQ, DEPTH = 2;
constexpr int NCOL = 6656;
constexpr int NEXP = 256, TOPK = 8, EDIM = 256, NEXPS = NEXP + 1;
constexpr float LN_EPS = 1e-5f;
constexpr float ALPHA = 1.4142135623730951f;
constexpr float LOG2E = 1.4426950408889634f;
constexpr float ROUTE_SCALE = 2.5f;
constexpr int NSLOT_MAX = T * TOPK + NEXP * 256;
constexpr int NSLOT_ALL = NSLOT_MAX + T;

constexpr size_t MiB = 1u << 20;
constexpr size_t WS_CTL = 0, CTL_ZERO_BYTES = 1 * MiB;
constexpr size_t WS_WIN = 2 * MiB;
constexpr size_t WS_WPA = 28 * MiB;
constexpr size_t WS_WPB = 32 * MiB;
constexpr size_t WS_WOUT = 34 * MiB;
constexpr size_t WS_WR = 38 * MiB;
constexpr size_t WS_REIDX = 40 * MiB;
constexpr size_t WS_RPOS = 42 * MiB;
constexpr size_t WS_RW = 44 * MiB;
constexpr size_t WS_STOK = 46 * MiB;
constexpr size_t WS_SDST = 49 * MiB;
constexpr size_t WS_SW = 52 * MiB;
constexpr size_t WS_LOGIT = 56 * MiB;
constexpr size_t WS_HB = 120 * MiB;
constexpr size_t WS_EGU = 248 * MiB;
constexpr size_t WS_ED = 505 * MiB;
constexpr size_t WS_BIG = 636 * MiB;
constexpr size_t WS_QA = WS_BIG, WS_KA = WS_BIG + 128 * MiB, WS_VA = WS_BIG + 256 * MiB;
constexpr size_t WS_QN = WS_BIG + 384 * MiB, WS_KN = WS_BIG + 448 * MiB, WS_VN = WS_BIG + 512 * MiB;
constexpr size_t WS_GA = WS_BIG + 576 * MiB, WS_GB = WS_BIG + 704 * MiB;
constexpr size_t WS_MIX = WS_QA;
constexpr size_t WS_YSH = WS_EGU;
constexpr size_t WS_OA8 = WS_BIG + 832 * MiB, WS_OB8 = WS_BIG + 896 * MiB, WS_U8 = WS_BIG + 928 * MiB;
constexpr size_t WS_U = WS_KA;
constexpr size_t WS_HMID = WS_BIG;
constexpr size_t WS_Y = WS_BIG + 320 * MiB;
constexpr size_t WS_HB8 = WS_Y + 1024 * MiB;
constexpr size_t WS_END = WS_HB8 + 64 * MiB;
static_assert((size_t)NSLOT_ALL * 512 <= 320 * MiB, "hmid");
static_assert((size_t)NSLOT_MAX * 4 <= 3 * MiB, "slots");
constexpr int CW_TMO = 0;
constexpr int CW_BAR = 4096;
constexpr int CW_CNT = 16384;
constexpr int CW_ERR = 20000;

constexpr int RING_BYTES = 131072;
constexpr int MISC_OFF = RING_BYTES;
constexpr int TAB_OFF = MISC_OFF + 1024;
constexpr int XOFF_LDS = RING_BYTES + 8192;
constexpr int LDS_BYTES = 147456;

__device__ __forceinline__ unsigned f2bf(float f) { unsigned u = __builtin_bit_cast(unsigned, f); return (u + 0x7fffu + ((u >> 16) & 1u)) >> 16; }
__device__ __forceinline__ unsigned pk2(float lo, float hi) { return f2bf(lo) | (f2bf(hi) << 16); }
__device__ __forceinline__ float bf2f(unsigned short b) { return __builtin_bit_cast(float, (unsigned)b << 16); }
__device__ __forceinline__ float bflo(unsigned w) { return __builtin_bit_cast(float, w << 16); }
__device__ __forceinline__ float bfhi(unsigned w) { return __builtin_bit_cast(float, w & 0xffff0000u); }
typedef __bf16 bf16x2_t __attribute__((ext_vector_type(2)));
typedef int i32x4 __attribute__((ext_vector_type(4)));
typedef int i32x8 __attribute__((ext_vector_type(8)));
__device__ __forceinline__ unsigned cvt_pk_bf16(float lo, float hi) { const f32x2 v = {lo, hi}; const bf16x2_t b = __builtin_convertvector(v, bf16x2_t); return __builtin_bit_cast(unsigned, b); }
__device__ __forceinline__ float fast_sigmoid(float x) { return __builtin_amdgcn_rcpf(1.0f + __builtin_amdgcn_exp2f(-x * LOG2E)); }

namespace pg8 {
constexpr int BM = 256, BK = 64, HALF = 128, HTB = HALF * BK * 2, STAGE_BYTES = 8 * HTB, NXCD = 8, WGM = 8;
__host__ __device__ __forceinline__ int lds_byte(int r, int c) { const int st = (r >> 4) * 2 + (c >> 5), rr = r & 15, cc = c & 31, ob = rr * 64 + cc * 2; return st * 1024 + (ob ^ (((ob >> 9) & 1) << 5)); }
__host__ __device__ __forceinline__ void stage_rc(int b, int& R, int& C) { const int st = b / 1024, sb = b % 1024, swz = sb ^ (((sb >> 9) & 1) << 5); R = (st >> 1) * 16 + swz / 64; C = (st & 1) * 32 + (swz % 64) / 2; }
__host__ __device__ __forceinline__ int perm32(int rho) { const int n = rho >> 4, i = rho & 15; return 8 * (i >> 2) + 4 * n + (i & 3); }

struct Unit { int pm, pn, e, row0; };

struct DenseOrder {
    static constexpr bool GATHER = false;
    int nM, nN, nwg, G, c; const bf16_t* A; const bf16_t* Bt; int K;
    __device__ void init(const bf16_t* A_, const bf16_t* Bt_, int M, int N, int K_, int G_, int c_) { A = A_; Bt = Bt_; K = K_; nM = M / BM; nN = N / BM; nwg = nM * nN; G = G_; c = c_; }
    __device__ __forceinline__ bool next(int i, Unit& u) const {
        const long L = (long)i * G + c; if (L >= nwg) return false;
        int wgid = (int)L; { const int q = nwg / NXCD, r = nwg % NXCD, xcd = wgid % NXCD, off = wgid / NXCD; wgid = (xcd < r ? xcd * (q + 1) : r * (q + 1) + (xcd - r) * q) + off; }
        const int nig = WGM * nN, gid = wgid / nig, fm = gid * WGM, gsz = (nM - fm) < WGM ? (nM - fm) : WGM;
        u.pm = fm + ((wgid % nig) % gsz); u.pn = (wgid % nig) / gsz; u.e = 0; u.row0 = u.pm * BM; return true;
    }
    __device__ __forceinline__ const char* a_base() const { return (const char*)A; }
    __device__ __forceinline__ unsigned a_row(const Unit& u, int r) const { return (unsigned)(u.row0 + r); }
    __device__ __forceinline__ const char* b_tile(const Unit& u) const { return (const char*)Bt + (size_t)u.pn * BM * K * 2; }
};

template <class E, class = void> struct epi_has_prefetch { static constexpr bool value = false; };
template <class E> struct epi_has_prefetch<E, decltype((void)E::PREFETCH)> { static constexpr bool value = true; };
template <class Epi, class Sched, bool F8 = false>
__device__ __forceinline__ void gemm_phase(LAS unsigned char* lds, LAS unsigned char* xlds, const int K, const Sched& S, const Epi& E) {
    constexpr bool GATHER = Sched::GATHER;
    int tid_ = threadIdx.x; asm volatile("" : "+v"(tid_));
    const int tid = tid_, wid = __builtin_amdgcn_readfirstlane(tid >> 6), lane = tid & 63, wr = wid >> 2, wc = wid & 3, fr = lane & 15, fq = lane >> 4;
    const int nt = K / BK;
    unsigned voffA[2], voffB[2];
#pragma unroll
    for (int i = 0; i < 2; ++i) { int R, C; stage_rc(tid * 16 + i * 8192, R, C); const int Rb = Epi::WIDE16 ? (64 * (R >> 5) + 16 * ((R & 15) >> 2) + 4 * ((R >> 4) & 1) + (R & 3)) : (Epi::PERM ? ((R & ~31) + perm32(R & 31)) : R);
        voffA[i] = (unsigned)(R * K + C) * 2u; voffB[i] = (unsigned)(Rb * K + C) * 2u; }
    const size_t kstep = (size_t)(BK * 2);
    const size_t hstep = (size_t)HALF * K * 2;
    const size_t bhs = Epi::WIDE16 ? (size_t)8 * K * 2 : hstep;
    const unsigned rowb = (unsigned)K * 2u;
    const unsigned ldsw = (unsigned)wid * 1024u;
    const int aoff = lds_byte(wr * 64 + fr, fq * 8), boff = lds_byte(wc * 32 + fr, fq * 8);
    LAS u32x4* myx = (LAS u32x4*)(xlds + tid * 16);
#define PG8_SA(b, h) (((b) * 2 + (h)) * HTB)
#define PG8_SB(b, h) ((4 + (b) * 2 + (h)) * HTB)
#define PG8_STAGE(bufoff, gbase, voff) do { _Pragma("unroll") for (int _i = 0; _i < 2; ++_i) \
        __builtin_amdgcn_global_load_lds((const unsigned*)((const char*)(gbase) + (voff)[_i]), (LAS unsigned*)(lds + (bufoff) + ldsw + _i * 8192), 16, 0, 0); } while (0)
#define PG8_STAGE_A(bufoff, dbase, gkt, vv, h) do { if constexpr (GATHER) { PG8_STAGE(bufoff, gkt, (vv)[h]); } else { PG8_STAGE(bufoff, (dbase) + (h) * hstep, voffA); } } while (0)
#define PG8_LD8(p) __builtin_shufflevector(*(const LAS i32x4*)(p), *(const LAS i32x4*)((p) + 1024), 0, 1, 2, 3, 4, 5, 6, 7)
#define PG8_LDA(dst, b, h) do { _Pragma("unroll") for (int m = 0; m < 4; ++m) dst[m] = PG8_LD8(lds + PG8_SA(b, h) + aoff + m * 2048); } while (0)
#define PG8_LDB(dst, b, h) do { _Pragma("unroll") for (int n = 0; n < 2; ++n) dst[n] = PG8_LD8(lds + PG8_SB(b, h) + boff + n * 2048); } while (0)
#define PG8_LO(v) __builtin_bit_cast(bf16x8, __builtin_shufflevector(v, v, 0, 1, 2, 3))
#define PG8_HI(v) __builtin_bit_cast(bf16x8, __builtin_shufflevector(v, v, 4, 5, 6, 7))
#define PG8_MMA(ai, bj, At, Bt) do { __builtin_amdgcn_s_setprio(1); _Pragma("unroll") for (int m = 0; m < 4; ++m) _Pragma("unroll") for (int n = 0; n < 2; ++n) { \
        if constexpr (F8) asm volatile("v_mfma_f32_16x16x128_f8f6f4 %0, %1, %2, %0" : "+v"(acc[ai][bj][m][n]) : "v"(Bt[n]), "v"(At[m])); \
        else { acc[ai][bj][m][n] = __builtin_amdgcn_mfma_f32_16x16x32_bf16(PG8_LO(Bt[n]), PG8_LO(At[m]), acc[ai][bj][m][n], 0, 0, 0); \
               acc[ai][bj][m][n] = __builtin_amdgcn_mfma_f32_16x16x32_bf16(PG8_HI(Bt[n]), PG8_HI(At[m]), acc[ai][bj][m][n], 0, 0, 0); } } __builtin_amdgcn_s_setprio(0); } while (0)
#define PG8_WAIT_V(n) asm volatile("s_waitcnt vmcnt(" #n ")" ::: "memory")
#define PG8_WAIT_L(n) asm volatile("s_waitcnt lgkmcnt(" #n ")" ::: "memory")
#define PG8_BAR __builtin_amdgcn_s_barrier()
#define PG8_SCHED __builtin_amdgcn_sched_barrier(0)
    Unit cur, nxt; int ui = 0;
    if (!S.next(0, cur)) return;
    f32x4 acc[2][2][4][2];
#pragma unroll
    for (int a = 0; a < 2; ++a)
#pragma unroll
        for (int b = 0; b < 2; ++b)
#pragma unroll
            for (int m = 0; m < 4; ++m)
#pragma unroll
                for (int n = 0; n < 2; ++n) acc[a][b][m][n] = (f32x4){0.f, 0.f, 0.f, 0.f};
    i32x8 At[4], B0[2], B1[2];
    const char* const Abase = S.a_base();
    unsigned vc[2][2];
    if constexpr (GATHER) {
#pragma unroll
        for (int h = 0; h < 2; ++h)
#pragma unroll
            for (int i = 0; i < 2; ++i) { int R, C; stage_rc(tid * 16 + i * 8192, R, C); vc[h][i] = S.a_row(cur, h * HALF + R) * rowb + (unsigned)(C * 2); }
    } else { vc[0][0] = vc[0][1] = vc[1][0] = vc[1][1] = 0u; }
    const char* cA = GATHER ? Abase : Abase + (size_t)cur.row0 * rowb;
    const char* cB = S.b_tile(cur);
    PG8_STAGE(PG8_SB(0, 0), cB, voffB); PG8_STAGE(PG8_SB(0, 1), cB + bhs, voffB); PG8_STAGE_A(PG8_SA(0, 0), cA, Abase, vc, 0); PG8_STAGE_A(PG8_SA(0, 1), cA, Abase, vc, 1);
    if (wr == 1) PG8_BAR;
    PG8_WAIT_V(2); PG8_BAR;
    PG8_STAGE(PG8_SB(1, 0), cB + kstep, voffB); PG8_STAGE_A(PG8_SA(1, 0), cA + kstep, Abase + kstep, vc, 0); PG8_STAGE(PG8_SB(1, 1), cB + bhs + kstep, voffB);
    PG8_WAIT_V(6); PG8_BAR;
    for (;;) {
        const bool has_next = S.next(ui + 1, nxt);
        const char* nA = cA; const char* nB = cB;
        if (has_next) { nB = S.b_tile(nxt); if constexpr (!GATHER) nA = Abase + (size_t)nxt.row0 * rowb; }
        if constexpr (GATHER) {
            if (has_next) S.prefetch_rows(nxt, xlds + 4096 + ((ui + 1) & 1) * 2048, tid, wid);
        }
        if constexpr (epi_has_prefetch<Epi>::value) E.prefetch(cur, xlds + (ui & 1) * 2048, tid, wid);
#pragma unroll 1
        for (int t = 0; t < nt; t += 2) {
            const bool last = (t == nt - 2);
            const char* a1 = (GATHER ? Abase : cA) + (size_t)(t + 1) * kstep;
            const char* a2 = last ? (GATHER ? Abase : nA) : (GATHER ? Abase : cA) + (size_t)(t + 2) * kstep; const char* b2 = last ? nB : cB + (size_t)(t + 2) * kstep;
            const char* a3 = a2 + kstep; const char* b3 = b2 + kstep;
            unsigned v2[2][2];
            if constexpr (GATHER) {
                if (last && has_next) { const LAS unsigned char* xb = xlds + 4096 + ((ui + 1) & 1) * 2048; int R0, C0, R1, C1; stage_rc(tid * 16, R0, C0); stage_rc(tid * 16 + 8192, R1, C1);
                    v2[0][0] = S.a_row_lds(nxt, R0, xb) * rowb + (unsigned)(C0 * 2); v2[0][1] = S.a_row_lds(nxt, R1, xb) * rowb + (unsigned)(C1 * 2);
                    v2[1][0] = S.a_row_lds(nxt, HALF + R0, xb) * rowb + (unsigned)(C0 * 2); v2[1][1] = S.a_row_lds(nxt, HALF + R1, xb) * rowb + (unsigned)(C1 * 2); }
                else { v2[0][0] = vc[0][0]; v2[0][1] = vc[0][1]; v2[1][0] = vc[1][0]; v2[1][1] = vc[1][1]; }
            } else { v2[0][0] = v2[0][1] = v2[1][0] = v2[1][1] = 0u; }
            PG8_LDB(B0, 0, 0); PG8_LDB(B1, 0, 1); PG8_SCHED; PG8_LDA(At, 0, 0); PG8_STAGE_A(PG8_SA(1, 1), a1, a1, vc, 1);
            PG8_WAIT_V(8); PG8_WAIT_L(0); PG8_BAR; PG8_MMA(0, 0, At, B0); PG8_MMA(0, 1, At, B1); PG8_BAR; PG8_SCHED;
            PG8_LDA(At, 0, 1); PG8_STAGE(PG8_SB(0, 0), b2, voffB); PG8_STAGE(PG8_SB(0, 1), b2 + bhs, voffB); PG8_STAGE_A(PG8_SA(0, 0), a2, a2, v2, 0);
            PG8_WAIT_V(8); PG8_WAIT_L(0); PG8_BAR; PG8_MMA(1, 0, At, B0); PG8_MMA(1, 1, At, B1); PG8_BAR; PG8_SCHED;
            PG8_LDB(B0, 1, 0); PG8_LDB(B1, 1, 1); PG8_SCHED; PG8_LDA(At, 1, 0); PG8_STAGE_A(PG8_SA(0, 1), a2, a2, v2, 1);
            PG8_WAIT_V(8); PG8_WAIT_L(0); PG8_BAR; PG8_MMA(0, 0, At, B0); PG8_MMA(0, 1, At, B1); PG8_BAR; PG8_SCHED;
            PG8_LDA(At, 1, 1); PG8_STAGE(PG8_SB(1, 0), b3, voffB); PG8_STAGE(PG8_SB(1, 1), b3 + bhs, voffB); PG8_STAGE_A(PG8_SA(1, 0), a3, a3, v2, 0);
            PG8_WAIT_V(8); PG8_WAIT_L(0); PG8_BAR; PG8_MMA(1, 0, At, B0); PG8_MMA(1, 1, At, B1); PG8_BAR; PG8_SCHED;
            if constexpr (GATHER) { if (last) { vc[0][0] = v2[0][0]; vc[0][1] = v2[0][1]; vc[1][0] = v2[1][0]; vc[1][1] = v2[1][1]; } }
        }
        if constexpr (F8) asm volatile("s_nop 15\n\ts_nop 15" ::: "memory");
        if (wr == 0) PG8_BAR;
        if constexpr (epi_has_prefetch<Epi>::value) E(acc, cur, wr, wc, fr, fq, (const LAS unsigned char*)(xlds + (ui & 1) * 2048)); else E(acc, cur, wr, wc, fr, fq);
        if (!has_next) break;
#pragma unroll
        for (int a = 0; a < 2; ++a)
#pragma unroll
            for (int b = 0; b < 2; ++b)
#pragma unroll
                for (int m = 0; m < 4; ++m)
#pragma unroll
                    for (int n = 0; n < 2; ++n) acc[a][b][m][n] = (f32x4){0.f, 0.f, 0.f, 0.f};
        cur = nxt; cA = nA; cB = nB; ++ui;
        if (wr == 1) PG8_BAR;
    }
    PG8_WAIT_V(0);
    PG8_BAR;
#undef PG8_SA
#undef PG8_SB
#undef PG8_STAGE
#undef PG8_STAGE_A
#undef PG8_LDA
#undef PG8_LD8
#undef PG8_LO
#undef PG8_HI
#undef PG8_LDB
#undef PG8_MMA
#undef PG8_WAIT_V
#undef PG8_WAIT_L
#undef PG8_BAR
#undef PG8_SCHED
}
}

using pg8::Unit;
typedef const f32x4 (&AccRef)[2][2][4][2];
constexpr float W8_SCALE = 256.0f, W8_INV = 1.0f / 256.0f;
constexpr float OA8_SCALE = 8.0f, OB8_SCALE = 32.0f, U8_SCALE = 32.0f;
constexpr float QA8_SCALE = 4.0f;
constexpr float G8_SCALE = 256.0f;
constexpr float H8_SCALE = 8.0f;
constexpr float Y_SCALE = 32.0f;

struct EpiInProj {
    static constexpr bool PERM = true, WIDE16 = false;
    unsigned char* ws; const float* bgate;
    __device__ __forceinline__ void operator()(AccRef acc, const Unit& u, int wr, int wc, int fr, int fq) const {
        const int pn = u.pn; size_t off; int ldc, ct; float sc = W8_INV; int gate = -1;
        if (pn < 4) { off = WS_QA; ldc = 1024; ct = pn; sc = 0.125f * LOG2E * W8_INV * QA8_SCALE; }
        else if (pn < 8) { off = WS_KA; ldc = 1024; ct = pn - 4; sc = W8_INV / QA8_SCALE; }
        else if (pn < 12) { off = WS_VA; ldc = 1024; ct = pn - 8; }
        else if (pn < 14) { off = WS_QN; ldc = 512; ct = pn - 12; sc = 0.17677669529663687f * LOG2E * W8_INV; }
        else if (pn < 16) { off = WS_KN; ldc = 512; ct = pn - 14; }
        else if (pn < 18) { off = WS_VN; ldc = 512; ct = pn - 16; }
        else if (pn < 22) { off = WS_GA; ldc = 1024; ct = pn - 18; gate = 0; }
        else { off = WS_GB; ldc = 1024; ct = pn - 22; gate = 1; }
        bf16_t* base = (bf16_t*)(ws + off);
        const int row0 = u.pm * 256 + wr * 64 + fr, col0 = ct * 256 + wc * 32 + 8 * fq;
        if (gate >= 0) {
            f32x4 bv[2][2];
#pragma unroll
            for (int bj = 0; bj < 2; ++bj)
#pragma unroll
                for (int n = 0; n < 2; ++n) bv[bj][n] = *(const f32x4*)(bgate + gate * 1024 + col0 + bj * 128 + 4 * n);
#pragma unroll
            for (int ai = 0; ai < 2; ++ai)
#pragma unroll
                for (int m = 0; m < 4; ++m) { unsigned char* rowp8 = (unsigned char*)base + (size_t)(row0 + ai * 128 + m * 16) * 1024 + col0;
#pragma unroll
                    for (int bj = 0; bj < 2; ++bj) { f32x4 v0 = acc[ai][bj][m][0] * W8_INV + bv[bj][0], v1 = acc[ai][bj][m][1] * W8_INV + bv[bj][1];
#pragma unroll
                        for (int j = 0; j < 4; ++j) { v0[j] = fast_sigmoid(v0[j]) * G8_SCALE; v1[j] = fast_sigmoid(v1[j]) * G8_SCALE; }
                        int p0 = 0, p1 = 0;
                        p0 = __builtin_amdgcn_cvt_pk_fp8_f32(v0[0], v0[1], p0, false); p0 = __builtin_amdgcn_cvt_pk_fp8_f32(v0[2], v0[3], p0, true);
                        p1 = __builtin_amdgcn_cvt_pk_fp8_f32(v1[0], v1[1], p1, false); p1 = __builtin_amdgcn_cvt_pk_fp8_f32(v1[2], v1[3], p1, true);
                        u32x2 w; w.x = (unsigned)p0; w.y = (unsigned)p1; *(u32x2*)(rowp8 + bj * 128) = w; } }
        } else if (pn < 8) {
#pragma unroll
            for (int ai = 0; ai < 2; ++ai)
#pragma unroll
                for (int m = 0; m < 4; ++m) { unsigned char* rowp8 = (unsigned char*)base + (size_t)(row0 + ai * 128 + m * 16) * 1024 + col0;
#pragma unroll
                    for (int bj = 0; bj < 2; ++bj) { const f32x4 v0 = acc[ai][bj][m][0] * sc, v1 = acc[ai][bj][m][1] * sc;
                        int p0 = 0, p1 = 0;
                        p0 = __builtin_amdgcn_cvt_pk_fp8_f32(v0[0], v0[1], p0, false); p0 = __builtin_amdgcn_cvt_pk_fp8_f32(v0[2], v0[3], p0, true);
                        p1 = __builtin_amdgcn_cvt_pk_fp8_f32(v1[0], v1[1], p1, false); p1 = __builtin_amdgcn_cvt_pk_fp8_f32(v1[2], v1[3], p1, true);
                        u32x2 w; w.x = (unsigned)p0; w.y = (unsigned)p1; *(u32x2*)(rowp8 + bj * 128) = w; } }
        } else {
            const bool hm = pn >= 14; const int bjs = hm ? 262144 : 128;
#pragma unroll
            for (int ai = 0; ai < 2; ++ai)
#pragma unroll
                for (int m = 0; m < 4; ++m) { const int row = row0 + ai * 128 + m * 16;
                    bf16_t* rowp = hm ? base + (size_t)(row >> 11) * 1048576 + (size_t)(col0 >> 5) * 65536 + (row & 2047) * 32 + (col0 & 31) : base + (size_t)row * ldc + col0;
#pragma unroll
                    for (int bj = 0; bj < 2; ++bj) { const f32x4 v0 = acc[ai][bj][m][0] * sc, v1 = acc[ai][bj][m][1] * sc;
                        u32x4 w; w.x = cvt_pk_bf16(v0[0], v0[1]); w.y = cvt_pk_bf16(v0[2], v0[3]); w.z = cvt_pk_bf16(v1[0], v1[1]); w.w = cvt_pk_bf16(v1[2], v1[3]);
                        *(u32x4*)(rowp + bj * bjs) = w; } }
        }
    }
};

constexpr float V8_SCALE = 8.0f;
struct EpiVT {
    static constexpr bool PERM = true, WIDE16 = false;
    unsigned char* VT;
    __device__ __forceinline__ void operator()(AccRef acc, const Unit& u, int wr, int wc, int fr, int fq) const {
        const int d0 = u.pm * 256 + wr * 64 + fr, t0 = u.pn * 256 + wc * 32 + 8 * fq;
#pragma unroll
        for (int ai = 0; ai < 2; ++ai)
#pragma unroll
            for (int m = 0; m < 4; ++m) { const int dg = d0 + ai * 128 + m * 16;
#pragma unroll
                for (int bj = 0; bj < 2; ++bj) { const int t = t0 + bj * 128, bb = t >> 11, sq = t & 2047, t6 = sq & 63;
                    unsigned char* p = VT + ((size_t)((bb * 8 + (dg >> 7)) * 128 + (dg & 127)) * 2048) + (sq >> 6) * 64 + 16 * (t6 >> 5) + 4 * ((t6 & 31) >> 3);
                    const f32x4 v0 = acc[ai][bj][m][0] * (W8_INV * V8_SCALE), v1 = acc[ai][bj][m][1] * (W8_INV * V8_SCALE);
                    int p0 = 0, p1 = 0;
                    p0 = __builtin_amdgcn_cvt_pk_fp8_f32(v0[0], v0[1], p0, false); p0 = __builtin_amdgcn_cvt_pk_fp8_f32(v0[2], v0[3], p0, true);
                    p1 = __builtin_amdgcn_cvt_pk_fp8_f32(v1[0], v1[1], p1, false); p1 = __builtin_amdgcn_cvt_pk_fp8_f32(v1[2], v1[3], p1, true);
                    *(int*)p = p0; *(int*)(p + 32) = p1; } }
    }
};
struct InProjOrder : pg8::DenseOrder {
    __device__ __forceinline__ bool next(int i, Unit& u) const { if (!pg8::DenseOrder::next(i, u)) return false; if (u.pn >= 8) u.pn += 4; return true; }
};

template <bool ADD> struct EpiProj {
    static constexpr bool PERM = true, WIDE16 = false;
    bf16_t* U; const unsigned char* G; unsigned char* U8; float asc;
    __device__ __forceinline__ void operator()(AccRef acc, const Unit& u, int wr, int wc, int fr, int fq) const {
        const int row0 = u.pm * 256 + wr * 64 + fr, col0 = u.pn * 256 + wc * 32 + 8 * fq;
#pragma unroll
        for (int ai = 0; ai < 2; ++ai) {
            u32x2 g[4][2]; u32x4 o[4][2];
#pragma unroll
            for (int m = 0; m < 4; ++m)
#pragma unroll
                for (int bj = 0; bj < 2; ++bj) { const size_t ro = (size_t)(row0 + ai * 128 + m * 16) * 1024 + col0 + bj * 128; g[m][bj] = *(const u32x2*)(G + ro);
                    if (ADD) o[m][bj] = *(const u32x4*)(U + ro); }
#pragma unroll
            for (int m = 0; m < 4; ++m)
#pragma unroll
                for (int bj = 0; bj < 2; ++bj) { const size_t ro = (size_t)(row0 + ai * 128 + m * 16) * 1024 + col0 + bj * 128; const f32x4 v0 = acc[ai][bj][m][0] * asc, v1 = acc[ai][bj][m][1] * asc; const u32x2 gg = g[m][bj];
                    const f32x2 g0 = __builtin_amdgcn_cvt_pk_f32_fp8((int)gg.x, false), g1 = __builtin_amdgcn_cvt_pk_f32_fp8((int)gg.x, true), g2 = __builtin_amdgcn_cvt_pk_f32_fp8((int)gg.y, false), g3 = __builtin_amdgcn_cvt_pk_f32_fp8((int)gg.y, true);
                    float r[8];
                    r[0] = g0.x * v0[0]; r[1] = g0.y * v0[1]; r[2] = g1.x * v0[2]; r[3] = g1.y * v0[3];
                    r[4] = g2.x * v1[0]; r[5] = g2.y * v1[1]; r[6] = g3.x * v1[2]; r[7] = g3.y * v1[3];
                    if (ADD) { const u32x4 oo = o[m][bj];
                        r[0] += bflo(oo.x); r[1] += bfhi(oo.x); r[2] += bflo(oo.y); r[3] += bfhi(oo.y); r[4] += bflo(oo.z); r[5] += bfhi(oo.z); r[6] += bflo(oo.w); r[7] += bfhi(oo.w);
                        int p0 = 0, p1 = 0;
                        p0 = __builtin_amdgcn_cvt_pk_fp8_f32(r[0] * U8_SCALE, r[1] * U8_SCALE, p0, false); p0 = __builtin_amdgcn_cvt_pk_fp8_f32(r[2] * U8_SCALE, r[3] * U8_SCALE, p0, true);
                        p1 = __builtin_amdgcn_cvt_pk_fp8_f32(r[4] * U8_SCALE, r[5] * U8_SCALE, p1, false); p1 = __builtin_amdgcn_cvt_pk_fp8_f32(r[6] * U8_SCALE, r[7] * U8_SCALE, p1, true);
                        u32x2 w; w.x = (unsigned)p0; w.y = (unsigned)p1; *(u32x2*)(U8 + ro) = w; }
                    else { u32x4 w; w.x = cvt_pk_bf16(r[0], r[1]); w.y = cvt_pk_bf16(r[2], r[3]); w.z = cvt_pk_bf16(r[4], r[5]); w.w = cvt_pk_bf16(r[6], r[7]);
                        *(u32x4*)(U + ro) = w; } }
            asm volatile("" ::: "memory"); }
    }
};

struct EpiResid {
    static constexpr bool PERM = false, WIDE16 = false;
    float* H;
    __device__ __forceinline__ void operator()(AccRef acc, const Unit& u, int wr, int wc, int fr, int fq) const {
        const int row0 = u.row0 + wr * 64 + fr, col0 = u.pn * 256 + wc * 32 + 4 * fq;
#pragma unroll
        for (int ai = 0; ai < 2; ++ai)
#pragma unroll
            for (int m = 0; m < 4; ++m) { float* rowp = H + (size_t)(row0 + ai * 128 + m * 16) * 1024 + col0;
#pragma unroll
                for (int bj = 0; bj < 2; ++bj)
#pragma unroll
                    for (int n = 0; n < 2; ++n) { const f32x4 h = *(const f32x4*)(rowp + bj * 128 + n * 16); *(f32x4*)(rowp + bj * 128 + n * 16) = h * ALPHA + acc[ai][bj][m][n]; }
                asm volatile("" ::: "memory"); }
    }
};

struct EpiFp8Plain {
    static constexpr bool PERM = true, WIDE16 = true;
    unsigned char* O; float osc;
    __device__ __forceinline__ void operator()(AccRef acc, const Unit& u, int wr, int wc, int fr, int fq) const {
        const int row0 = u.row0 + wr * 64 + fr, col0 = u.pn * 256 + wc * 64 + 16 * fq;
#pragma unroll
        for (int ai = 0; ai < 2; ++ai)
#pragma unroll
            for (int m = 0; m < 4; ++m) { u32x4 w;
#pragma unroll
                for (int bj = 0; bj < 2; ++bj)
#pragma unroll
                    for (int n = 0; n < 2; ++n) { const f32x4 v = acc[ai][bj][m][n] * osc; int p = 0;
                        p = __builtin_amdgcn_cvt_pk_fp8_f32(v[0], v[1], p, false); p = __builtin_amdgcn_cvt_pk_fp8_f32(v[2], v[3], p, true); w[2 * bj + n] = (unsigned)p; }
                *(u32x4*)(O + (size_t)(row0 + ai * 128 + m * 16) * 1024 + col0) = w; }
    }
};

struct EpiF32 {
    static constexpr bool PERM = false, WIDE16 = false;
    float* C; int ldc;
    __device__ __forceinline__ void operator()(AccRef acc, const Unit& u, int wr, int wc, int fr, int fq) const {
        const int row0 = u.pm * 256 + wr * 64 + fr, col0 = u.pn * 256 + wc * 32 + 4 * fq;
#pragma unroll
        for (int ai = 0; ai < 2; ++ai)
#pragma unroll
            for (int m = 0; m < 4; ++m) { float* rowp = C + (size_t)(row0 + ai * 128 + m * 16) * ldc + col0;
#pragma unroll
                for (int bj = 0; bj < 2; ++bj)
#pragma unroll
                    for (int n = 0; n < 2; ++n) *(f32x4*)(rowp + bj * 128 + n * 16) = acc[ai][bj][m][n]; }
    }
};

struct EpiF32T {
    static constexpr bool PERM = false, WIDE16 = false;
    float* CT; int ldr;
    __device__ __forceinline__ void operator()(AccRef acc, const Unit& u, int wr, int wc, int fr, int fq) const {
        const int row0 = u.pm * 256 + wr * 64 + fr, col0 = u.pn * 256 + wc * 32 + 4 * fq;
#pragma unroll
        for (int ai = 0; ai < 2; ++ai)
#pragma unroll
            for (int m = 0; m < 4; ++m) { float* base = CT + (size_t)col0 * ldr + (row0 + ai * 128 + m * 16);
#pragma unroll
                for (int bj = 0; bj < 2; ++bj)
#pragma unroll
                    for (int n = 0; n < 2; ++n)
#pragma unroll
                        for (int j = 0; j < 4; ++j) base[(size_t)(bj * 128 + n * 16 + j) * ldr] = acc[ai][bj][m][n][j]; }
    }
};

struct EpiSwiglu {
    static constexpr bool PERM = true, WIDE16 = false;
    unsigned char* Hm;
    __device__ __forceinline__ void operator()(AccRef acc, const Unit& u, int wr, int wc, int fr, int fq) const {
        const int row0 = u.pm * 256 + wr * 64 + fr, col0 = u.pn * 128 + wc * 32 + 8 * fq;
#pragma unroll
        for (int ai = 0; ai < 2; ++ai)
#pragma unroll
            for (int m = 0; m < 4; ++m) { unsigned char* rowp = Hm + (size_t)(row0 + ai * 128 + m * 16) * 256 + col0;
                float r[8];
#pragma unroll
                for (int n = 0; n < 2; ++n)
#pragma unroll
                    for (int j = 0; j < 4; ++j) { const float g = acc[ai][0][m][n][j] * W8_INV, up = acc[ai][1][m][n][j] * (W8_INV * H8_SCALE); r[4 * n + j] = g * fast_sigmoid(g) * up; }
                int p0 = 0, p1 = 0;
                p0 = __builtin_amdgcn_cvt_pk_fp8_f32(r[0], r[1], p0, false); p0 = __builtin_amdgcn_cvt_pk_fp8_f32(r[2], r[3], p0, true);
                p1 = __builtin_amdgcn_cvt_pk_fp8_f32(r[4], r[5], p1, false); p1 = __builtin_amdgcn_cvt_pk_fp8_f32(r[6], r[7], p1, true);
                u32x2 w; w.x = (unsigned)p0; w.y = (unsigned)p1; *(u32x2*)rowp = w; }
    }
};

struct EpiDown {
    static constexpr bool PERM = true, WIDE16 = true, PREFETCH = true;
    unsigned char* Y; const u32x2* sinf;
    __device__ __forceinline__ void prefetch(const Unit& u, LAS unsigned char* buf, int tid, int wid) const {
        __builtin_amdgcn_global_load_lds((const unsigned*)(sinf + (size_t)u.pm * 256) + tid, (LAS unsigned*)(buf + wid * 256), 4, 0, 0);
    }
    __device__ __forceinline__ void operator()(AccRef acc, const Unit& u, int wr, int wc, int fr, int fq, const LAS unsigned char* buf) const {
        const int r0 = wr * 64 + fr, col0 = u.pn * 256 + wc * 64 + 16 * fq;
        int dst[8]; float wg[8];
#pragma unroll
        for (int i = 0; i < 8; ++i) { const u32x2 si = *(const LAS u32x2*)(buf + (r0 + (i >> 2) * 128 + (i & 3) * 16) * 8); const unsigned sx = si.x, sy = si.y; dst[i] = (int)sx; wg[i] = __uint_as_float(sy); }
#pragma unroll
        for (int ai = 0; ai < 2; ++ai)
#pragma unroll
            for (int m = 0; m < 4; ++m) { const int d = dst[ai * 4 + m]; const float wgt = wg[ai * 4 + m] * (Y_SCALE * W8_INV / H8_SCALE);
                if (d >= 0) { u32x4 w;
#pragma unroll
                    for (int bj = 0; bj < 2; ++bj)
#pragma unroll
                        for (int n = 0; n < 2; ++n) { const f32x4 v = acc[ai][bj][m][n] * wgt; int p = 0;
                            p = __builtin_amdgcn_cvt_pk_fp8_f32(v[0], v[1], p, false); p = __builtin_amdgcn_cvt_pk_fp8_f32(v[2], v[3], p, true); w[2 * bj + n] = (unsigned)p; }
                    *(u32x4*)(Y + (size_t)d * 1024 + col0) = w; } }
    }
};

__device__ __forceinline__ int tab_find(const LAS int* tab, int pm) {
    int lo = 0, hi = 256;
    while (lo < hi) { const int mid = (lo + hi + 1) >> 1; if (tab[mid] <= pm) lo = mid; else hi = mid - 1; }
    return lo;
}
__device__ __forceinline__ int xcd_remap(int L, int nwg) { const int q = nwg / 8, r = nwg % 8, xcd = L % 8, off = L / 8; return (xcd < r ? xcd * (q + 1) : r * (q + 1) + (xcd - r) * q) + off; }

struct ExpertOrderGU {
    static constexpr bool GATHER = true;
    const LAS int* tab; const bf16_t* A; const bf16_t* W; const int* stok; int G, c, nwg;
    __device__ __forceinline__ bool next(int i, Unit& u) const {
        const long L = (long)i * G + c; if (L >= nwg) return false;
        const int id = xcd_remap((int)L, nwg);
        u.pm = id >> 1; u.pn = id & 1; u.e = __builtin_amdgcn_readfirstlane(tab_find(tab, u.pm)); u.row0 = (u.pm - tab[256]) * 256; return true;
    }
    __device__ __forceinline__ const char* a_base() const { return (const char*)A; }
    __device__ __forceinline__ unsigned a_row(const Unit& u, int r) const { return u.e == 256 ? (unsigned)(u.row0 + r) : (unsigned)stok[u.pm * 256 + r]; }
    __device__ __forceinline__ void prefetch_rows(const Unit& u, LAS unsigned char* buf, int tid, int wid) const {
        if (u.e != 256) __builtin_amdgcn_global_load_lds((const unsigned*)(stok + (size_t)u.pm * 256) + (tid & 255), (LAS unsigned*)(buf + wid * 256), 4, 0, 0);
    }
    __device__ __forceinline__ unsigned a_row_lds(const Unit& u, int r, const LAS unsigned char* buf) const { return u.e == 256 ? (unsigned)(u.row0 + r) : ((const LAS unsigned*)buf)[r]; }
    __device__ __forceinline__ const char* b_tile(const Unit& u) const { return (const char*)W + ((size_t)u.e * 512 + (size_t)u.pn * 256) * 1024; }
};
struct ExpertOrderDown {
    static constexpr bool GATHER = false;
    const LAS int* tab; const bf16_t* A; const bf16_t* W; int G, c, nwg;
    __device__ __forceinline__ bool next(int i, Unit& u) const {
        const long L = (long)i * G + c; if (L >= nwg) return false;
        const int id = xcd_remap((int)L, nwg);
        u.pm = id >> 2; u.pn = id & 3; u.e = __builtin_amdgcn_readfirstlane(tab_find(tab, u.pm)); u.row0 = u.pm * 256; return true;
    }
    __device__ __forceinline__ const char* a_base() const { return (const char*)A; }
    __device__ __forceinline__ unsigned a_row(const Unit& u, int r) const { return (unsigned)(u.row0 + r); }
    __device__ __forceinline__ const char* b_tile(const Unit& u) const { return (const char*)W + ((size_t)u.e * 1024 + (size_t)u.pn * 256) * 256; }
};

#define XB_TMO      128
#define XB_XCNT(j)  (256  + 64 * (j))
#define XB_XSUB(j)  (1280 + 64 * (j))
#define XB_XGEN(j)  (2304 + 64 * (j))
#define XB_TOP      3328
#define XB_TOPGEN   3392
#define XCD_BAR_WORDS 3456
#define XB_SPIN_CAP (1u << 22)
__device__ __forceinline__ unsigned xb_ld(unsigned* p)              { return __hip_atomic_load(p, __ATOMIC_RELAXED, __HIP_MEMORY_SCOPE_AGENT); }
__device__ __forceinline__ unsigned xb_add(unsigned* p, unsigned v) { return __hip_atomic_fetch_add(p, v, __ATOMIC_RELAXED, __HIP_MEMORY_SCOPE_AGENT); }
__device__ __forceinline__ unsigned xb_xcc_id() { return (unsigned)__builtin_amdgcn_s_getreg((3 << 11) | 20) & 0xFu; }
#define XB_SPIN(cond, bar) do { unsigned _sp = 0; while (cond) { __builtin_amdgcn_s_sleep(1); \
    if ((++_sp & 255u) == 0u) { if (xb_ld(&(bar)[XB_TMO])) break; if (_sp > XB_SPIN_CAP) { atomicAdd(&(bar)[XB_TMO], 1u); break; } } } } while (0)
struct XcdBarrier { unsigned* bar; unsigned x; volatile LAS unsigned* st; };
__device__ __forceinline__ XcdBarrier xcd_barrier_post(unsigned* bar, volatile LAS unsigned* st) {
    XcdBarrier b; b.bar = bar; b.x = xb_xcc_id(); b.st = st;
    if (threadIdx.x == 0) (void)xb_add(&bar[XB_XCNT(b.x)], 1u);
    return b;
}
__device__ __forceinline__ void xcd_barrier_complete(unsigned* bar, unsigned x, unsigned& nloc, unsigned& nx) {
    const unsigned G = gridDim.x * gridDim.y * gridDim.z;
    unsigned sum, cnt, mine, sp = 0u;
    for (;;) {
        sum = 0u; cnt = 0u; mine = 0u;
#pragma unroll
        for (unsigned j = 0; j < 16; ++j) { const unsigned c = xb_ld(&bar[XB_XCNT(j)]); sum += c; cnt += (c > 0u) ? 1u : 0u; mine = (j == x) ? c : mine; }
        if (sum == G) break;
        __builtin_amdgcn_s_sleep(1);
        if ((++sp & 255u) == 0u) { if (xb_ld(&bar[XB_TMO])) break; if (sp > XB_SPIN_CAP) { atomicAdd(&bar[XB_TMO], 1u); break; } }
    }
    nloc = mine > 0u ? mine : 1u; nx = cnt > 0u ? cnt : 1u;
}
__device__ __forceinline__ void xcd_barrier(const XcdBarrier& b) {
    asm volatile("s_waitcnt vmcnt(0)" ::: "memory");
    __syncthreads();
    if (threadIdx.x == 0) {
        unsigned* bar = b.bar;
        __builtin_amdgcn_s_waitcnt(0);
        unsigned nloc = b.st[0], nx = b.st[1];
        if (nloc == 0u) { xcd_barrier_complete(bar, b.x, nloc, nx); b.st[0] = nloc; b.st[1] = nx; }
        const unsigned old = xb_add(&bar[XB_XSUB(b.x)], 1u);
        const unsigned gen = old / nloc;
        if (old + 1u == (gen + 1u) * nloc) {
            __builtin_amdgcn_fence(__ATOMIC_RELEASE, "agent");
            asm volatile("s_waitcnt vmcnt(0)" ::: "memory");
            const unsigned og = xb_add(&bar[XB_TOP], 1u);
            const unsigned tg = og / nx;
            if (og + 1u == (tg + 1u) * nx) xb_add(&bar[XB_TOPGEN], 1u);
            else XB_SPIN(xb_ld(&bar[XB_TOPGEN]) == tg, bar);
            __builtin_amdgcn_fence(__ATOMIC_ACQUIRE, "agent");
            xb_add(&bar[XB_XGEN(b.x)], 1u);
            asm volatile("s_waitcnt vmcnt(0)" ::: "memory");
        } else {
            XB_SPIN(xb_ld(&bar[XB_XGEN(b.x)]) == gen, bar);
            __builtin_amdgcn_fence(__ATOMIC_ACQUIRE, "agent");
            asm volatile("s_waitcnt vmcnt(0)" ::: "memory");
        }
    }
    __syncthreads();
}

struct Args { const float* in[26]; float* out; unsigned char* ws; int ph_lo, ph_hi; };
typedef const __attribute__((address_space(4))) Args* KArgs;
__device__ __forceinline__ KArgs kargs() { KArgs p = (KArgs)__builtin_amdgcn_kernarg_segment_ptr(); asm volatile("" : "+s"(p)); return p; }
enum { I_X = 0, I_EG, I_EB, I_WIN, I_BG, I_LQ1, I_LK1, I_LQ2, I_LK2, I_SUBG, I_WPA, I_RPB, I_WPB, I_WOUT, I_L1G, I_L1B, I_RW, I_RB, I_EWG, I_EWU, I_EWD, I_SWG, I_SWU, I_SWD, I_L2G, I_L2B };
constexpr int NWAVES = 8;

__device__ __forceinline__ float wave_sum(float v) {
#pragma unroll
    for (int o = 1; o < 64; o <<= 1) v += __shfl_xor(v, o);
    return v;
}

template <bool F8 = false>
__device__ __forceinline__ void transpose_item(const float* W, int N, int k0, int n0, bf16_t* dst, int Kd, int drow0, LAS float* scr, int lane) {
    float tv[32];
#pragma unroll
    for (int i = 0; i < 32; ++i) { const int kk = 2 * i + (lane >> 5); tv[i] = __builtin_nontemporal_load(W + (size_t)(k0 + kk) * N + n0 + (lane & 31)); }
#pragma unroll
    for (int i = 0; i < 32; ++i) { const int kk = 2 * i + (lane >> 5); scr[kk * 33 + (lane & 31)] = tv[i]; }
    asm volatile("s_waitcnt lgkmcnt(0)" ::: "memory");
    const int c = lane & 7;
#pragma unroll
    for (int j = 0; j < 4; ++j) { const int n = (lane >> 3) + 8 * j; const LAS float* s = scr + (8 * c) * 33 + n;
        if constexpr (F8) { int p0 = 0, p1 = 0;
            p0 = __builtin_amdgcn_cvt_pk_fp8_f32(s[0 * 33] * W8_SCALE, s[1 * 33] * W8_SCALE, p0, false); p0 = __builtin_amdgcn_cvt_pk_fp8_f32(s[2 * 33] * W8_SCALE, s[3 * 33] * W8_SCALE, p0, true);
            p1 = __builtin_amdgcn_cvt_pk_fp8_f32(s[4 * 33] * W8_SCALE, s[5 * 33] * W8_SCALE, p1, false); p1 = __builtin_amdgcn_cvt_pk_fp8_f32(s[6 * 33] * W8_SCALE, s[7 * 33] * W8_SCALE, p1, true);
            u32x2 o; o.x = (unsigned)p0; o.y = (unsigned)p1; *(u32x2*)((unsigned char*)dst + (size_t)(drow0 + n) * Kd + k0 + 8 * c) = o; }
        else { u32x4 o; o.x = pk2(s[0 * 33], s[1 * 33]); o.y = pk2(s[2 * 33], s[3 * 33]); o.z = pk2(s[4 * 33], s[5 * 33]); o.w = pk2(s[6 * 33], s[7 * 33]);
            *(u32x4*)(dst + (size_t)(drow0 + n) * Kd + k0 + 8 * c) = o; } }
    asm volatile("s_waitcnt lgkmcnt(0)" ::: "memory");
}

struct ConvItem { const float* W; unsigned char* dst; int N, k0, n0, Kd, drow0; bool valid; };
__device__ __forceinline__ void conv_load(const ConvItem& d, float (&tv)[32], int lane) {
#pragma unroll
    for (int i = 0; i < 32; ++i) { const int kk = 2 * i + (lane >> 5); tv[i] = __builtin_nontemporal_load(d.W + (size_t)(d.k0 + kk) * d.N + d.n0 + (lane & 31)); }
}
__device__ __forceinline__ void conv_store(const ConvItem& d, const float (&tv)[32], LAS float* scr, int lane) {
#pragma unroll
    for (int i = 0; i < 32; ++i) { const int kk = 2 * i + (lane >> 5); scr[kk * 33 + (lane & 31)] = tv[i]; }
    asm volatile("s_waitcnt lgkmcnt(0)" ::: "memory");
    const int c = lane & 7;
#pragma unroll
    for (int j = 0; j < 4; ++j) { const int n = (lane >> 3) + 8 * j; const LAS float* s = scr + (8 * c) * 33 + n; int p0 = 0, p1 = 0;
        p0 = __builtin_amdgcn_cvt_pk_fp8_f32(s[0 * 33] * W8_SCALE, s[1 * 33] * W8_SCALE, p0, false); p0 = __builtin_amdgcn_cvt_pk_fp8_f32(s[2 * 33] * W8_SCALE, s[3 * 33] * W8_SCALE, p0, true);
        p1 = __builtin_amdgcn_cvt_pk_fp8_f32(s[4 * 33] * W8_SCALE, s[5 * 33] * W8_SCALE, p1, false); p1 = __builtin_amdgcn_cvt_pk_fp8_f32(s[6 * 33] * W8_SCALE, s[7 * 33] * W8_SCALE, p1, true);
        u32x2 o; o.x = (unsigned)p0; o.y = (unsigned)p1; *(u32x2*)(d.dst + (size_t)(d.drow0 + n) * d.Kd + d.k0 + 8 * c) = o; }
    asm volatile("s_waitcnt lgkmcnt(0)" ::: "memory");
}

__device__ __forceinline__ void convert_small(KArgs a, LAS unsigned char* lds, int gw, int ngw, int lane, int wave) {
    LAS float* scr = (LAS float*)(lds + wave * 16384);
    constexpr int PER_L = 3328 + 512 + 256 + 512 + 128;
    for (int it = gw; it < 2 * PER_L; it += ngw) {
        const int l = it / PER_L; int r = it % PER_L;
        if (r < 3328) { const int kb = r / 208, nb = r % 208; transpose_item<true>(a->in[I_WIN] + (size_t)l * 1024 * NCOL, NCOL, 64 * kb, 32 * nb, (bf16_t*)(a->ws + WS_WIN + (size_t)l * NCOL * 1024), 1024, 32 * nb, scr, lane); continue; } r -= 3328;
        if (r < 512) { const int kb = r / 32, nb = r % 32; transpose_item<true>(a->in[I_WPA] + (size_t)l * 1024 * 1024, 1024, 64 * kb, 32 * nb, (bf16_t*)(a->ws + WS_WPA + (size_t)l * 1024 * 1024), 1024, 32 * nb, scr, lane); continue; } r -= 512;
        if (r < 256) { const int kb = r / 32, nb = r % 32; transpose_item<true>(a->in[I_WPB] + (size_t)l * 512 * 1024, 1024, 64 * kb, 32 * nb, (bf16_t*)(a->ws + WS_WPB + (size_t)l * 1024 * 512), 512, 32 * nb, scr, lane); continue; } r -= 256;
        if (r < 512) { const int kb = r / 32, nb = r % 32; transpose_item<true>(a->in[I_WOUT] + (size_t)l * 1024 * 1024, 1024, 64 * kb, 32 * nb, (bf16_t*)(a->ws + WS_WOUT + (size_t)l * 1024 * 1024), 1024, 32 * nb, scr, lane); continue; } r -= 512;
        { const int kb = r / 8, nb = r % 8; transpose_item(a->in[I_RW] + (size_t)l * 1024 * 256, 256, 64 * kb, 32 * nb, (bf16_t*)(a->ws + WS_WR) + (size_t)l * 256 * 1024, 1024, 32 * nb, scr, lane); }
    }
}
constexpr int N_EXP_ITEMS = 771 * 128;
__device__ __forceinline__ ConvItem expert_item(KArgs a, int l, int it) {
    ConvItem d; d.valid = it < N_EXP_ITEMS; if (!d.valid) it = 0;
    const int mat = it >> 7, sub = it & 127;
    if (mat < 512 || mat == 768 || mat == 769) {
        const bool up = (mat >= 256 && mat < 512) || mat == 769; const int e = mat < 256 ? mat : (mat < 512 ? mat - 256 : 256);
        d.W = mat < 256 ? a->in[I_EWG] + ((size_t)l * 256 + e) * 262144 : (mat < 512 ? a->in[I_EWU] + ((size_t)l * 256 + e) * 262144 : (mat == 768 ? a->in[I_SWG] + (size_t)l * 262144 : a->in[I_SWU] + (size_t)l * 262144));
        const int kb = sub >> 3, nb = sub & 7, n0 = 32 * nb;
        d.N = 256; d.k0 = 64 * kb; d.n0 = n0; d.dst = a->ws + WS_EGU + (size_t)e * 512 * 1024; d.Kd = 1024; d.drow0 = (n0 >> 7) * 256 + (n0 & 127) + (up ? 128 : 0);
    } else {
        const int e = mat == 770 ? 256 : mat - 512;
        d.W = mat == 770 ? a->in[I_SWD] + (size_t)l * 262144 : a->in[I_EWD] + ((size_t)l * 256 + e) * 262144;
        const int kb = sub >> 5, nb = sub & 31;
        d.N = 1024; d.k0 = 64 * kb; d.n0 = 32 * nb; d.dst = a->ws + WS_ED + (size_t)e * 1024 * 256; d.Kd = 256; d.drow0 = 32 * nb;
    }
    return d;
}
__device__ __forceinline__ void convert_expert_items3(KArgs a, int l, int it0, int it1, int it2, LAS float* scr, int lane) {
    asm volatile("s_waitcnt vmcnt(0) lgkmcnt(0)\n\ts_nop 15\n\ts_nop 15" ::: "memory");
    const ConvItem d0 = expert_item(a, l, it0), d1 = expert_item(a, l, it1), d2 = expert_item(a, l, it2);
    float t0[32], t1[32], t2[32];
    if (d0.valid) conv_load(d0, t0, lane);
    if (d1.valid) conv_load(d1, t1, lane);
    if (d2.valid) conv_load(d2, t2, lane);
    if (d0.valid) conv_store(d0, t0, scr, lane);
    if (d1.valid) conv_store(d1, t1, scr, lane);
    if (d2.valid) conv_store(d2, t2, scr, lane);
}

__device__ __forceinline__ void ln_store(f32x4 (&v)[4], const float* g, const float* b, float* out32, bf16_t* outb, unsigned char* out8, int lane) {
    float s = 0.f;
#pragma unroll
    for (int j = 0; j < 4; ++j) s += (v[j].x + v[j].y) + (v[j].z + v[j].w);
    const float mean = wave_sum(s) * (1.f / 1024.f); float s2 = 0.f;
#pragma unroll
    for (int j = 0; j < 4; ++j) { v[j] = v[j] - mean; s2 += (v[j].x * v[j].x + v[j].y * v[j].y) + (v[j].z * v[j].z + v[j].w * v[j].w); }
    const float rstd = 1.f / sqrtf(wave_sum(s2) * (1.f / 1024.f) + LN_EPS);
#pragma unroll
    for (int j = 0; j < 4; ++j) { const f32x4 gg = *(const f32x4*)(g + 4 * lane + 256 * j), bb = *(const f32x4*)(b + 4 * lane + 256 * j);
        const f32x4 o = v[j] * rstd * gg + bb;
        if (out32) *(f32x4*)(out32 + 4 * lane + 256 * j) = o;
        if (outb) { u32x2 w; w.x = pk2(o.x, o.y); w.y = pk2(o.z, o.w); *(u32x2*)(outb + 4 * lane + 256 * j) = w; }
        if (out8) { int p = 0; p = __builtin_amdgcn_cvt_pk_fp8_f32(o.x, o.y, p, false); p = __builtin_amdgcn_cvt_pk_fp8_f32(o.z, o.w, p, true); *(int*)(out8 + 4 * lane + 256 * j) = p; } }
}

__device__ __forceinline__ f32x4 ldfp8x4(const unsigned char* p) { const int y = *(const int*)p; const f32x2 lo = __builtin_amdgcn_cvt_pk_f32_fp8(y, false), hi = __builtin_amdgcn_cvt_pk_f32_fp8(y, true); return (f32x4){lo.x, lo.y, hi.x, hi.y} * (1.0f / 32.0f); }
__device__ __forceinline__ f32x4 ldbf4(const bf16_t* p) { const u32x2 y = *(const u32x2*)p; return (f32x4){bflo(y.x), bfhi(y.x), bflo(y.y), bfhi(y.y)}; }

constexpr int AT_KP = 144;
constexpr int AT_KP8 = 80;
constexpr int AT_KB = 64 * AT_KP8;
constexpr int AT_VB = 128 * AT_KP8;
constexpr int AT_K0 = 0, AT_V0 = 2 * AT_KB;
constexpr int AT_O1 = 30720;
constexpr int AT_KN = 96256, AT_RED = 96256 + 128;
typedef short v4i16_t __attribute__((ext_vector_type(4)));
__device__ __forceinline__ s16x4 ds_tr(const LAS unsigned char* p) { return __builtin_bit_cast(s16x4, __builtin_amdgcn_ds_read_tr16_b64_v4i16((LAS v4i16_t*)p)); }
__device__ __forceinline__ bf16x8 cat8(s16x4 a, s16x4 b) { return (bf16x8){a[0], a[1], a[2], a[3], b[0], b[1], b[2], b[3]}; }
#define CROWF(r) ((float)(((r) & 3) + 8 * ((r) >> 2)))
__device__ __forceinline__ float xhalf_max(float v) { const auto r = __builtin_amdgcn_permlane32_swap(__float_as_uint(v), __float_as_uint(v), false, false); return fmaxf(__uint_as_float(r[0]), __uint_as_float(r[1])); }
__device__ __forceinline__ float xhalf_sum(float v) { const auto r = __builtin_amdgcn_permlane32_swap(__float_as_uint(v), __float_as_uint(v), false, false); return __uint_as_float(r[0]) + __uint_as_float(r[1]); }

__device__ __forceinline__ int attn_tile(int i, int qb) {
    const int c0 = 4 * qb; if (i < 4) return c0 + i;
    const int nr = 32 - (c0 + 4), nl = c0, j = i - 4;
    const int pairs = nr < nl ? nr : nl;
    if (j < 2 * pairs) return (j & 1) ? c0 - 1 - (j >> 1) : c0 + 4 + (j >> 1);
    const int k = j - 2 * pairs; return nr > nl ? c0 + 4 + pairs + k : c0 - 1 - pairs - k;
}
__device__ __forceinline__ void diffattn_unit(KArgs a, int l, int b, int h, int qb, float lam, LAS unsigned char* lds, const int tid) {
    asm volatile("s_waitcnt vmcnt(0) lgkmcnt(0)\n\ts_nop 15\n\ts_nop 15" ::: "memory");
    const int lane = tid & 63, r32 = lane & 31, hi = lane >> 5; const int wid = __builtin_amdgcn_readfirstlane(tid >> 6);
    const unsigned char* QA = (const unsigned char*)(a->ws + WS_QA); const unsigned char* KA = (const unsigned char*)(a->ws + WS_KA); const unsigned char* VT = (const unsigned char*)(a->ws + WS_VA);
    const size_t tok0 = (size_t)b * SEQ;
    const int qw0 = qb * 256 + wid * 32, qpos = qw0 + r32;
    const float slope2 = exp2f(-(float)(h + 1)) * LOG2E;
    const int krow = tid >> 3, kch = tid & 7;
    const int vrow0 = tid >> 2, vch = tid & 3;
    const unsigned koff = (unsigned)(krow * 1024 + kch * 8), voff = (unsigned)(vrow0 * 2048 + vch * 16);
    const unsigned kdst = (unsigned)(krow * AT_KP8 + kch * 8);
    const unsigned vdst = (unsigned)(vrow0 * AT_KP8 + vch * 16);
    const unsigned kfr = (unsigned)(r32 * AT_KP8 + hi * 32);
    const unsigned vfr = (unsigned)(r32 * AT_KP8 + hi * 32);
    const float fq4 = (float)(qpos - 4 * hi);
    bf16x8 kx0, kx1;
    { const unsigned one2 = 0x3f803f80u, z = 0u; const unsigned k0 = f2bf((float)r32), k1 = f2bf((float)(r32 + 32));
      const u32x4 w0 = hi ? (u32x4){z, z, z, z} : (u32x4){one2, 0x3f80u | (k0 << 16), k0, z}, w1 = hi ? (u32x4){z, z, z, z} : (u32x4){one2, 0x3f80u | (k1 << 16), k1, z};
      kx0 = __builtin_bit_cast(bf16x8, w0); kx1 = __builtin_bit_cast(bf16x8, w1); }
    const unsigned s2h = f2bf(slope2); const unsigned s2l = f2bf(slope2 - bflo(s2h));
    LAS unsigned* o1l = (LAS unsigned*)(lds + AT_O1 + wid * 8192) + lane;
    f32x16 o[4];
    float linv_keep = 0.f;
    if (wid >= 4) __builtin_amdgcn_s_setprio(1);
#pragma unroll 1
    for (int p = 0; p < 2; ++p) {
        const unsigned char* Kp = KA + tok0 * 1024 + h * 128 + p * 64;
        const unsigned char* Vp = VT + (size_t)((b * 8 + h) * 128) * 2048;
        const char* const Kpc = (const char*)Kp; const char* const Vpc = (const char*)Vp;
#define AT_LDK(t_) (*(const u32x2*)(Kpc + (size_t)((unsigned)((t_) << 16) + koff)))
#define AT_LDV0(t_) (*(const u32x4*)(Vpc + (size_t)((unsigned)((t_) << 6) + voff)))
        i32x8 qf;
        { const i32x4 q0 = *(const i32x4*)(QA + (tok0 + qpos) * 1024 + h * 128 + p * 64 + hi * 32), q1 = *(const i32x4*)(QA + (tok0 + qpos) * 1024 + h * 128 + p * 64 + hi * 32 + 16);
          qf = __builtin_shufflevector(q0, q1, 0, 1, 2, 3, 4, 5, 6, 7); }
        float m = 0.f, lsum = 0.f;
        float qn2 = 0.f;
#pragma unroll
        for (int j = 0; j < 8; ++j) { const f32x2 x0 = __builtin_amdgcn_cvt_pk_f32_fp8(qf[j], false), x1 = __builtin_amdgcn_cvt_pk_f32_fp8(qf[j], true); qn2 += (x0.x * x0.x + x0.y * x0.y) + (x1.x * x1.x + x1.y * x1.y); }
        qn2 = xhalf_sum(qn2) * (1.0f / (QA8_SCALE * QA8_SCALE));
#pragma unroll
        for (int o_ = 1; o_ < 32; o_ <<= 1) qn2 = fmaxf(qn2, __shfl_xor(qn2, o_));
        qn2 = __uint_as_float((unsigned)__builtin_amdgcn_readfirstlane((int)__float_as_uint(qn2)));
        if (tid < 32) ((LAS unsigned*)(lds + AT_KN))[tid] = 0u;
        __syncthreads();
        const bool can_skip = slope2 * 1793.0f > 48.0f;
#pragma unroll 1
        for (int j0 = 0; can_skip && j0 < SEQ / 64; j0 += 16) { u32x2 kk[16];
#pragma unroll
            for (int j = 0; j < 16; ++j) kk[j] = AT_LDK(j0 + j);
#pragma unroll
            for (int j = 0; j < 16; ++j) { float ss = 0.f;
#pragma unroll
                for (int c = 0; c < 2; ++c) { const f32x2 x0 = __builtin_amdgcn_cvt_pk_f32_fp8((int)kk[j][c], false), x1 = __builtin_amdgcn_cvt_pk_f32_fp8((int)kk[j][c], true); ss += (x0.x * x0.x + x0.y * x0.y) + (x1.x * x1.x + x1.y * x1.y); }
                ss *= QA8_SCALE * QA8_SCALE;
                ss += __shfl_xor(ss, 1); ss += __shfl_xor(ss, 2); ss += __shfl_xor(ss, 4);
                ss = fmaxf(ss, __shfl_xor(ss, 8)); ss = fmaxf(ss, __shfl_xor(ss, 16)); ss = fmaxf(ss, __shfl_xor(ss, 32));
                if (lane == 0) (void)__hip_atomic_fetch_max((LAS unsigned*)(lds + AT_KN) + j0 + j, __float_as_uint(ss), __ATOMIC_RELAXED, __HIP_MEMORY_SCOPE_WORKGROUP); } }
#pragma unroll
        for (int e = 0; e < 4; ++e) o[e] = (f32x16){};
        unsigned keep = 0xFFFFFFFFu; int n = 0, ic = 0, i1 = 1, i2 = 2;
        int kt = attn_tile(0, qb);
        u32x2 kreg = AT_LDK(kt);
        u32x4 vreg0 = AT_LDV0(kt);
        *(LAS u32x2*)(lds + AT_K0 + kdst) = kreg; *(LAS u32x4*)(lds + AT_V0 + vdst) = vreg0;
        { const int k1 = attn_tile(1, qb);
          kreg = AT_LDK(k1);
          vreg0 = AT_LDV0(k1); }
        __syncthreads();
#pragma unroll 1
        for (; ic < SEQ / 64; ++n) {
            const int it = n;
            const int cb = n & 1;
            if (n == 4 && can_skip) {
                const LAS float* red = (const LAS float*)(lds + AT_RED); float A2 = red[0], Mm = red[1];
#pragma unroll
                for (int w = 1; w < 8; ++w) { A2 = fmaxf(A2, red[2 * w]); Mm = fminf(Mm, red[2 * w + 1]); }
                const int i = lane & 31, t = attn_tile(i, qb);
                const int dmin = t * 64 > qb * 256 + 255 ? t * 64 - (qb * 256 + 255) : qb * 256 - (t * 64 + 63);
                const float kn2 = __uint_as_float(((const LAS unsigned*)(lds + AT_KN))[t]);
                const float bound = sqrtf(A2 * kn2) * 1.0001f - Mm - slope2 * (float)dmin;
                const bool kp = !(bound < -36.0f);
                keep = (unsigned)__builtin_amdgcn_readfirstlane((int)(unsigned)(__ballot(kp) & 0xFFFFFFFFull)) | 0x3Fu;
                i1 = 5; { const unsigned r = keep & ~0x3Fu; i2 = r ? __builtin_ctz(r) : 32; }
            }
            const int ktn = (i1 < SEQ / 64) ? attn_tile(i1, qb) : kt;
            if (i1 < SEQ / 64) {
                const int nb = cb ^ 1;
                *(LAS u32x2*)(lds + AT_K0 + nb * AT_KB + kdst) = kreg; *(LAS u32x4*)(lds + AT_V0 + nb * AT_VB + vdst) = vreg0;
                if (i2 < SEQ / 64) { const int k2 = attn_tile(i2, qb);
                    kreg = AT_LDK(k2);
                    vreg0 = AT_LDV0(k2); }
            }
            const LAS unsigned char* Kb = lds + AT_K0 + cb * AT_KB; const LAS unsigned char* Vb = lds + AT_V0 + cb * AT_VB;
            const int cls = (kt * 64 + 63 < qw0) ? 0 : ((kt * 64 > qw0 + 31) ? 1 : 2);
            f32x16 p0, p1;
            i32x8 ka, kb2;
            ka = __builtin_shufflevector(*(const LAS i32x4*)(Kb + kfr), *(const LAS i32x4*)(Kb + kfr + 16), 0, 1, 2, 3, 4, 5, 6, 7);
            kb2 = __builtin_shufflevector(*(const LAS i32x4*)(Kb + kfr + 32 * AT_KP8), *(const LAS i32x4*)(Kb + kfr + 32 * AT_KP8 + 16), 0, 1, 2, 3, 4, 5, 6, 7);
            { const float ts = cls == 0 ? slope2 * ((float)(kt * 64) - fq4 - 4.f * (float)hi) : (cls == 1 ? slope2 * (fq4 + 4.f * (float)hi - (float)(kt * 64)) : 0.f);
              const float S = ts - m; const unsigned sa = f2bf(S); const float r1 = S - bflo(sa); const unsigned sb = f2bf(r1); const unsigned sc = f2bf(r1 - bflo(sb));
              const unsigned sg_ = cls == 1 ? 0x8000u : 0u; const unsigned sh = cls == 2 ? 0u : (s2h ^ sg_), sl = cls == 2 ? 0u : (s2l ^ sg_);
              const u32x4 qw = (u32x4){sa | (sb << 16), sc | (sh << 16), sl, 0u};
              const bf16x8 qx = __builtin_bit_cast(bf16x8, qw);
              asm volatile("v_mfma_f32_32x32x64_f8f6f4 %0, %1, %2, 0" : "=&v"(p0) : "v"(ka), "v"(qf));
              asm volatile("v_mfma_f32_32x32x64_f8f6f4 %0, %1, %2, 0" : "=&v"(p1) : "v"(kb2), "v"(qf));
              asm volatile("s_nop 15\n\ts_nop 7" : "+v"(p0), "+v"(p1));
              p0 = __builtin_amdgcn_mfma_f32_32x32x16_bf16(kx0, qx, p0, 0, 0, 0); p1 = __builtin_amdgcn_mfma_f32_32x32x16_bf16(kx1, qx, p1, 0, 0, 0); }
            i32x8 vt[4];
#pragma unroll
            for (int e = 0; e < 4; ++e) vt[e] = __builtin_shufflevector(*(const LAS i32x4*)(Vb + vfr + e * 32 * AT_KP8), *(const LAS i32x4*)(Vb + vfr + e * 32 * AT_KP8 + 16), 0, 1, 2, 3, 4, 5, 6, 7);
            __builtin_amdgcn_sched_barrier(0);
            if (cls == 2) {
                const float fqh = fq4 - (float)(kt * 64);
#pragma unroll
                for (int r = 0; r < 16; ++r) { p0[r] = p0[r] - slope2 * fabsf(fqh - CROWF(r)); p1[r] = p1[r] - slope2 * fabsf(fqh - 32.f - CROWF(r)); }
            }
            float mx = fmaxf(fmaxf(p0[0], p0[1]), fmaxf(p1[0], p1[1]));
#pragma unroll
            for (int r = 2; r < 16; r += 2) { mx = fmaxf(fmaxf(mx, p0[r]), p0[r + 1]); mx = fmaxf(fmaxf(mx, p1[r]), p1[r + 1]); }
            mx = xhalf_max(mx);
            if (it == 0 || !__all(mx <= 8.0f)) {
                const float dl = it == 0 ? mx - 4.0f : fmaxf(mx - 4.0f, 0.f), alpha = it == 0 ? 1.0f : __builtin_amdgcn_exp2f(-dl); m += dl; lsum *= alpha;
                asm volatile("s_nop 15\n\ts_nop 7" ::: "memory");
#pragma unroll
                for (int e = 0; e < 4; ++e)
#pragma unroll
                    for (int r = 0; r < 16; ++r) o[e][r] *= alpha;
#pragma unroll
                for (int r = 0; r < 16; ++r) { p0[r] -= dl; p1[r] -= dl; }
            }
            float rs = 0.f;
#pragma unroll
            for (int r = 0; r < 16; ++r) { p0[r] = __builtin_amdgcn_exp2f(p0[r]); p1[r] = __builtin_amdgcn_exp2f(p1[r]); rs += p0[r] + p1[r]; }
            lsum += rs;
            i32x8 pb;
#pragma unroll
            for (int i = 0; i < 4; ++i) { int w0 = 0, w1 = 0;
                w0 = __builtin_amdgcn_cvt_pk_fp8_f32(p0[4 * i + 0], p0[4 * i + 1], w0, false); w0 = __builtin_amdgcn_cvt_pk_fp8_f32(p0[4 * i + 2], p0[4 * i + 3], w0, true);
                w1 = __builtin_amdgcn_cvt_pk_fp8_f32(p1[4 * i + 0], p1[4 * i + 1], w1, false); w1 = __builtin_amdgcn_cvt_pk_fp8_f32(p1[4 * i + 2], p1[4 * i + 3], w1, true);
                pb[i] = w0; pb[4 + i] = w1; }
            asm volatile("s_nop 3" : "+v"(pb));
#pragma unroll
            for (int e = 0; e < 4; ++e) asm volatile("v_mfma_f32_32x32x64_f8f6f4 %0, %1, %2, %0" : "+v"(o[e]) : "v"(vt[e]), "v"(pb));
            if (n == 3) {
                float mm = m;
#pragma unroll
                for (int o_ = 1; o_ < 32; o_ <<= 1) mm = fminf(mm, __shfl_xor(mm, o_));
                if (lane == 0) { LAS float* red = (LAS float*)(lds + AT_RED); red[2 * wid] = qn2; red[2 * wid + 1] = mm; }
            }
            kt = ktn; ic = i1; i1 = i2;
            { const unsigned r = (i2 < 31) ? (keep & (0xFFFFFFFEu << i2)) : 0u; i2 = r ? __builtin_ctz(r) : 32; }
            __syncthreads();
        }
        asm volatile("s_nop 15\n\ts_nop 7" ::: "memory");
        const float linv = (1.0f / V8_SCALE) / xhalf_sum(lsum);
        if (p == 0) {
#pragma unroll
            for (int e = 0; e < 4; ++e)
#pragma unroll
                for (int r = 0; r < 16; r += 2) o1l[(e * 8 + (r >> 1)) * 64] = cvt_pk_bf16(o[e][r] * linv, o[e][r + 1] * linv);
        } else linv_keep = linv;
    }
#undef AT_LDK
#undef AT_LDV0
#undef AT_LDV1
    __builtin_amdgcn_s_setprio(0);
    float ss = 0.f;
#pragma unroll
    for (int e = 0; e < 4; ++e)
#pragma unroll
        for (int r = 0; r < 16; r += 2) { const unsigned w = o1l[(e * 8 + (r >> 1)) * 64];
            o[e][r] = bflo(w) - lam * (o[e][r] * linv_keep); o[e][r + 1] = bfhi(w) - lam * (o[e][r + 1] * linv_keep);
            ss += o[e][r] * o[e][r] + o[e][r + 1] * o[e][r + 1]; }
    ss = xhalf_sum(ss);
    const float lam_init = 0.8f - 0.6f * expf(-0.3f * (float)l);
    const float rn = (1.0f / sqrtf(ss * (1.f / 128.f) + LN_EPS)) * (1.0f - lam_init);
    const float* sg = a->in[I_SUBG] + l * 128;
    unsigned char* orow = (unsigned char*)(a->ws + WS_OA8) + (tok0 + qpos) * 1024 + h * 128;
    const float rn8 = rn * OA8_SCALE;
#pragma unroll
    for (int e = 0; e < 4; ++e)
#pragma unroll
        for (int r4 = 0; r4 < 4; ++r4) { const int ecol = 32 * e + 8 * r4 + 4 * hi; const f32x4 g = *(const f32x4*)(sg + ecol);
            int pk = 0; pk = __builtin_amdgcn_cvt_pk_fp8_f32(o[e][4 * r4 + 0] * rn8 * g.x, o[e][4 * r4 + 1] * rn8 * g.y, pk, false); pk = __builtin_amdgcn_cvt_pk_fp8_f32(o[e][4 * r4 + 2] * rn8 * g.z, o[e][4 * r4 + 3] * rn8 * g.w, pk, true);
            *(int*)(orow + ecol) = pk; }
}

constexpr int NA_NINF_OFF = TAB_OFF + 3072;
constexpr int NA_RPB_OFF = 101312, NA_V_OFF = 0, NA_SCR_OFF = 32768;
__device__ __forceinline__ void na_wave_unit(KArgs a, int uidx, LAS unsigned char* lds, int wave, int lane) {
    asm volatile("s_waitcnt vmcnt(0) lgkmcnt(0)\n\ts_nop 15\n\ts_nop 15" ::: "memory");
    const int r32 = lane & 31, hi = lane >> 5;
    const int qbh = uidx & 1, head = (uidx >> 1) & 15, r = (uidx >> 5) & 31, b = uidx >> 10;
    const bf16_t* QN = (const bf16_t*)(a->ws + WS_QN); const bf16_t* KN = (const bf16_t*)(a->ws + WS_KN); const bf16_t* VN = (const bf16_t*)(a->ws + WS_VN);
    LAS unsigned char* Vw = lds + NA_V_OFF + wave * 4096;
    LAS unsigned char* Kw = lds + NA_SCR_OFF + wave * 8448;
    const int c = 32 * qbh + r32; const size_t tq = (size_t)b * SEQ + r * 64 + c;
    const int rs = min(max(r - 4, 0), 24), cs = min(max(c - 8, 0), 48);
    bf16x8 qf[2];
#pragma unroll
    for (int d0 = 0; d0 < 2; ++d0) qf[d0] = *(const bf16x8*)(QN + tq * 512 + head * 32 + d0 * 16 + hi * 8);
    const unsigned vfr = (unsigned)(((lane >> 4) & 1) * 32 + (lane & 3) * 8 + (4 * hi + ((lane & 15) >> 2)) * 64);
    float m = -1e30f, lsum = 0.f; f32x16 o = (f32x16){};
    const int fb = 32 * qbh, hb = qbh ? 24 : 32;
    unsigned ad0[16], ad1[4];
    { const unsigned base = (unsigned)(NA_RPB_OFF + (head * 465 + (rs - r + 7) * 31 + (15 - c)) * 4);
#pragma unroll
      for (int rr = 0; rr < 16; ++rr) { const int kc0 = fb + (rr & 3) + 8 * (rr >> 2) + 4 * hi;
          const bool v0 = (kc0 >= cs) && (kc0 < cs + 16);
          ad0[rr] = v0 ? base + (unsigned)(kc0 * 4) : (unsigned)NA_NINF_OFF; }
#pragma unroll
      for (int rr = 0; rr < 4; ++rr) { const int kc1 = hb + rr + 4 * hi;
          const bool v1 = (kc1 >= cs) && (kc1 < cs + 16);
          ad1[rr] = v1 ? base + (unsigned)(kc1 * 4) : (unsigned)NA_NINF_OFF; } }
    u32x4 kr4[3]; u32x4 vr[3];
    const unsigned char* KNh = (const unsigned char*)KN + ((size_t)(b * 16 + head) * 2048 + 16 * qbh) * 64 + lane * 16;
    const unsigned char* VNh = (const unsigned char*)VN + ((size_t)(b * 16 + head) * 2048 + 16 * qbh) * 64 + lane * 16;
    const int kst = 16 * qbh + (lane >> 2);
#pragma unroll
    for (int j = 0; j < 3; ++j) kr4[j] = *(const u32x4*)(KNh + (size_t)(rs * 4096 + j * 1024));
#pragma unroll
    for (int j = 0; j < 3; ++j) vr[j] = *(const u32x4*)(VNh + (size_t)(rs * 4096 + j * 1024));
#pragma unroll 1
    for (int kr = 0; kr < 8; ++kr) {
        const int R = rs + kr;
#pragma unroll
        for (int j = 0; j < 3; ++j) *(LAS u32x4*)(Vw + (kst + 16 * j) * 64 + (lane & 3) * 16) = vr[j];
#pragma unroll
        for (int j = 0; j < 3; ++j) *(LAS u32x4*)(Kw + (kst + 16 * j) * 80 + (lane & 3) * 16) = kr4[j];
        if (kr + 1 < 8) {
#pragma unroll
            for (int j = 0; j < 3; ++j) { kr4[j] = *(const u32x4*)(KNh + (size_t)((R + 1) * 4096 + j * 1024));
                vr[j] = *(const u32x4*)(VNh + (size_t)((R + 1) * 4096 + j * 1024)); }
        }
        bf16x8 kc[4];
#pragma unroll
        for (int d0 = 0; d0 < 2; ++d0) { kc[2 * d0] = *(const LAS bf16x8*)(Kw + (fb + r32) * 80 + d0 * 32 + hi * 16); kc[2 * d0 + 1] = *(const LAS bf16x8*)(Kw + (hb + r32) * 80 + d0 * 32 + hi * 16); }
        f32x16 p0, p1 = (f32x16){};
#pragma unroll
        for (int rr = 0; rr < 16; ++rr) { p0[rr] = *(const LAS float*)(lds + ad0[rr]); ad0[rr] += 124u; }
#pragma unroll
        for (int rr = 0; rr < 4; ++rr) { p1[rr] = *(const LAS float*)(lds + ad1[rr]); ad1[rr] += 124u; }
        asm volatile("s_waitcnt lgkmcnt(0)" ::: "memory");
#pragma unroll
        for (int d0 = 0; d0 < 2; ++d0) {
            p0 = __builtin_amdgcn_mfma_f32_32x32x16_bf16(kc[2 * d0], qf[d0], p0, 0, 0, 0);
            p1 = __builtin_amdgcn_mfma_f32_32x32x16_bf16(kc[2 * d0 + 1], qf[d0], p1, 0, 0, 0);
        }
        float mx = fmaxf(p0[0], p1[0]);
#pragma unroll
        for (int rr = 1; rr < 16; ++rr) mx = rr < 4 ? fmaxf(fmaxf(mx, p0[rr]), p1[rr]) : fmaxf(mx, p0[rr]);
        mx = xhalf_max(mx);
        const float mn = fmaxf(fmaxf(m, mx), -1e30f), alpha = __builtin_amdgcn_exp2f(m - mn); m = mn;
        float rsum = 0.f;
#pragma unroll
        for (int rr = 0; rr < 16; ++rr) { p0[rr] = __builtin_amdgcn_exp2f(p0[rr] - mn); rsum += p0[rr]; }
#pragma unroll
        for (int rr = 0; rr < 4; ++rr) { p1[rr] = __builtin_amdgcn_exp2f(p1[rr] - mn); rsum += p1[rr]; }
        lsum = lsum * alpha + rsum;
#pragma unroll
        for (int rr = 0; rr < 16; ++rr) o[rr] *= alpha;
        bf16x8 pb[3];
#pragma unroll
        for (int s = 0; s < 2; ++s) { u32x4 w; w.x = cvt_pk_bf16(p0[8 * s + 0], p0[8 * s + 1]); w.y = cvt_pk_bf16(p0[8 * s + 2], p0[8 * s + 3]); w.z = cvt_pk_bf16(p0[8 * s + 4], p0[8 * s + 5]); w.w = cvt_pk_bf16(p0[8 * s + 6], p0[8 * s + 7]);
            pb[s] = __builtin_bit_cast(bf16x8, w); }
        { u32x4 w; w.x = cvt_pk_bf16(p1[0], p1[1]); w.y = cvt_pk_bf16(p1[2], p1[3]); w.z = 0u; w.w = 0u; pb[2] = __builtin_bit_cast(bf16x8, w); }
        s16x4 lo[3], hi4[3];
#pragma unroll
        for (int s = 0; s < 2; ++s) { lo[s] = ds_tr(Vw + vfr + (fb + 16 * s) * 64); hi4[s] = ds_tr(Vw + vfr + (fb + 16 * s) * 64 + 512); }
        lo[2] = ds_tr(Vw + vfr + hb * 64); hi4[2] = ds_tr(Vw + vfr + hb * 64 + 512);
        asm volatile("s_waitcnt lgkmcnt(0)" ::: "memory");
#pragma unroll
        for (int s = 0; s < 3; ++s) o = __builtin_amdgcn_mfma_f32_32x32x16_bf16(cat8(lo[s], hi4[s]), pb[s], o, 0, 0, 0);
    }
    const float linv = OB8_SCALE / xhalf_sum(lsum);
    unsigned char* orow = (unsigned char*)(a->ws + WS_OB8) + (size_t)tq * 512 + head * 32;
#pragma unroll
    for (int r4 = 0; r4 < 4; ++r4) { const int ecol = 8 * r4 + 4 * hi;
        int pk = 0; pk = __builtin_amdgcn_cvt_pk_fp8_f32(o[4 * r4 + 0] * linv, o[4 * r4 + 1] * linv, pk, false); pk = __builtin_amdgcn_cvt_pk_fp8_f32(o[4 * r4 + 2] * linv, o[4 * r4 + 3] * linv, pk, true);
        *(int*)(orow + ecol) = pk; }
}

__device__ __forceinline__ void build_table(const unsigned* cnt, LAS unsigned char* lds) {
    LAS int* tab = (LAS int*)(lds + TAB_OFF); LAS int* tmp = (LAS int*)(lds + TAB_OFF + 2048);
    int tid_ = threadIdx.x; asm volatile("" : "+v"(tid_));
    const int tid = tid_;
    __syncthreads();
    if (tid < 256) tmp[tid] = (int)((__hip_atomic_load(cnt + tid, __ATOMIC_RELAXED, __HIP_MEMORY_SCOPE_AGENT) + 255u) >> 8);
    __syncthreads();
    if (tid < 256) { int s = 0; for (int j = 0; j < tid; ++j) s += tmp[j]; tab[tid] = s; if (tid == 255) { tab[256] = s + tmp[255]; tab[257] = s + tmp[255] + T / 256; } }
    __syncthreads();
}

__device__ __forceinline__ float route_sig(float x) { return 1.0f / (1.0f + expf(-x)); }
__device__ __forceinline__ void route_phase(KArgs a, int l, LAS unsigned char* lds, int G) {
    int tid_ = threadIdx.x; asm volatile("" : "+v"(tid_));
    const int tid = tid_;
    const float* LT = (const float*)(a->ws + WS_LOGIT); const float* rbias = a->in[I_RB] + l * 256;
    int* reidx = (int*)(a->ws + WS_REIDX); int* rpos = (int*)(a->ws + WS_RPOS); float* rw = (float*)(a->ws + WS_RW);
    unsigned* cnt = (unsigned*)(a->ws + WS_CTL) + CW_CNT + l * 256;
    LAS int* hist = (LAS int*)lds; LAS int* base = hist + 256; LAS int* le = base + 256; LAS int* lp = le + 2048; LAS float* lb = (LAS float*)(lp + 2048); LAS float* gsl = lb + 256;
    for (int panel = blockIdx.x; panel < T / 256; panel += G) {
        __syncthreads();
        if (tid < 256) { hist[tid] = 0; lb[tid] = rbias[tid]; }
        __syncthreads();
        { const int tok = tid & 255, half = __builtin_amdgcn_readfirstlane(tid >> 8); const float* lt = LT + (size_t)panel * 256 + tok;
#pragma unroll
          for (int g4 = 0; g4 < 4; ++g4) { const int g = 4 * half + g4; float m1 = -INFINITY, m2 = -INFINITY;
              float x[32];
#pragma unroll
              for (int j = 0; j < 32; ++j) x[j] = lt[(size_t)(g * 32 + j) * T];
#pragma unroll
              for (int j = 0; j < 32; ++j) { const float v = route_sig(x[j]) + lb[g * 32 + j]; const float t = fminf(m1, v); m1 = fmaxf(m1, v); m2 = fmaxf(m2, t); }
              gsl[tok * 9 + g] = m1 + m2; } }
        __syncthreads();
        if (tid < 256) {
            const size_t row = (size_t)panel * 256 + tid; const float* lt = LT + row;
            float gs[8];
#pragma unroll
            for (int g = 0; g < 8; ++g) gs[g] = gsl[tid * 9 + g];
            unsigned gmask = 0;
#pragma unroll
            for (int g = 0; g < 8; ++g) { int rank = 0;
#pragma unroll
                for (int j = 0; j < 8; ++j) rank += (gs[j] > gs[g] || (gs[j] == gs[g] && j < g)) ? 1 : 0;
                if (rank < 4) gmask |= 1u << g; }
            float tv[8]; int te[8];
#pragma unroll
            for (int k = 0; k < 8; ++k) { tv[k] = -INFINITY; te[k] = 0; }
#pragma unroll 1
            for (int g = 0; g < 8; ++g) { if (!((gmask >> g) & 1u)) continue;
                float x[32];
#pragma unroll
                for (int j = 0; j < 32; ++j) x[j] = lt[(size_t)(g * 32 + j) * T];
#pragma unroll
                for (int j = 0; j < 32; ++j) { const int e = g * 32 + j; float v = route_sig(x[j]) + lb[e];
                    if (v > tv[7]) { int ev = e; bool ins = false;
#pragma unroll
                        for (int k = 0; k < 8; ++k) { ins = ins || (v > tv[k]); const bool sw = ins;   const float tvv = tv[k]; const int tee = te[k]; tv[k] = sw ? v : tvv; te[k] = sw ? ev : tee; v = sw ? tvv : v; ev = sw ? tee : ev; } } } }
            float gv[8], gsum = 0.f;
#pragma unroll
            for (int k = 0; k < 8; ++k) { gv[k] = tv[k] - lb[te[k]]; gsum += gv[k]; }
            const float sc = ROUTE_SCALE / gsum;
#pragma unroll
            for (int k = 0; k < 8; ++k) { const int pos = atomicAdd((int*)&hist[te[k]], 1); le[tid * 8 + k] = te[k]; lp[tid * 8 + k] = pos; rw[row * 8 + k] = gv[k] * sc; }
        }
        __syncthreads();
        if (tid < 256) { const int c = hist[tid]; base[tid] = c ? (int)__hip_atomic_fetch_add(cnt + tid, (unsigned)c, __ATOMIC_RELAXED, __HIP_MEMORY_SCOPE_AGENT) : 0; }
        __syncthreads();
        for (int i = tid; i < 2048; i += 512) { const int e = le[i]; const size_t gi = (size_t)panel * 2048 + i; reidx[gi] = e; rpos[gi] = base[e] + lp[i]; }
    }
}

__device__ __forceinline__ void slot_phase(KArgs a, int l, LAS unsigned char* lds, int G) {
    int tid_ = threadIdx.x; asm volatile("" : "+v"(tid_));
    const int tid = tid_;
    const LAS int* tab = (const LAS int*)(lds + TAB_OFF);
    const int* reidx = (const int*)(a->ws + WS_REIDX); const int* rpos = (const int*)(a->ws + WS_RPOS); const float* rw = (const float*)(a->ws + WS_RW);
    int* stok = (int*)(a->ws + WS_STOK); u32x2* sinf = (u32x2*)(a->ws + WS_SDST);
    const unsigned* cnt = (const unsigned*)(a->ws + WS_CTL) + CW_CNT + l * 256;
    for (size_t i = (size_t)blockIdx.x * 512 + tid; i < (size_t)T * 8; i += (size_t)G * 512) {
        const int e = reidx[i]; const int slot = tab[e] * 256 + rpos[i];
        stok[slot] = (int)(i >> 3); sinf[slot] = (u32x2){(unsigned)i, __builtin_bit_cast(unsigned, rw[i])};
    }
    for (int e = blockIdx.x; e < 256; e += G) {
        const int c = (int)__hip_atomic_load(cnt + e, __ATOMIC_RELAXED, __HIP_MEMORY_SCOPE_AGENT); const int pend = ((c + 255) >> 8) << 8;
        for (int s = c + tid; s < pend; s += 512) { const int slot = tab[e] * 256 + s; stok[slot] = 0; sinf[slot] = (u32x2){0xffffffffu, 0u}; }
    }
}

constexpr int NPHASE = 1 + 11 * DEPTH;
#ifndef LBW
#define LBW 2
#endif
#ifndef PHMASK
#define PHMASK 0xFFF
#endif
#define EN(j) (((PHMASK) >> (j)) & 1)
__global__ void __launch_bounds__(NWAVES * 64, LBW) mega_fwd(Args a_kernarg) {
    extern __shared__ __attribute__((aligned(16))) unsigned char lds_raw[];
    LAS unsigned char* lds = (LAS unsigned char*)lds_raw;
    const int G = gridDim.x;
#define PH_IDS KArgs a = kargs(); int tid_ = threadIdx.x; asm volatile("" : "+v"(tid_)); const int tid = tid_, lane = tid & 63; const int wave = __builtin_amdgcn_readfirstlane(tid >> 6); \
    const int gw = blockIdx.x * NWAVES + wave, ngw = G * NWAVES; (void)lane; (void)gw; (void)ngw; (void)a;
    for (int u = threadIdx.x; u < 256; u += NWAVES * 64) ((LAS unsigned*)(lds + MISC_OFF))[u] = 0u;
    __syncthreads();
    int lo, hi;
    { KArgs a0 = kargs(); lo = a0->ph_lo; hi = a0->ph_hi; }
#if MK_ONE_LAUNCH
    XcdBarrier bar;
    { KArgs a0 = kargs(); bar = xcd_barrier_post((unsigned*)(a0->ws + WS_CTL) + CW_BAR, (volatile LAS unsigned*)(lds + MISC_OFF)); }
#define GRID_BAR() xcd_barrier(bar)
#else
#define GRID_BAR() do {} while (0)
#endif
#define IN(k) (lo <= (k) && (k) < hi)
#define SEAM(k) do { if (IN(k) && IN((k) + 1)) GRID_BAR(); } while (0)

    if (EN(11) && IN(0)) {
        PH_IDS
        float* H = a->out; bf16_t* HB = (bf16_t*)(a->ws + WS_HB);
        convert_small(a, lds, gw, ngw, lane, wave);
        for (int m = gw; m < T; m += 2 * ngw) { f32x4 v[4], w[4]; const int m2 = m + ngw; const bool two = m2 < T;
#pragma unroll
            for (int j = 0; j < 4; ++j) v[j] = *(const f32x4*)(a->in[I_X] + (size_t)m * 1024 + 4 * lane + 256 * j);
            if (two) {
#pragma unroll
                for (int j = 0; j < 4; ++j) w[j] = *(const f32x4*)(a->in[I_X] + (size_t)m2 * 1024 + 4 * lane + 256 * j); }
            ln_store(v, a->in[I_EG], a->in[I_EB], nullptr, HB + (size_t)m * 1024, (unsigned char*)(a->ws + WS_HB8) + (size_t)m * 1024, lane);
            if (two) ln_store(w, a->in[I_EG], a->in[I_EB], nullptr, HB + (size_t)m2 * 1024, (unsigned char*)(a->ws + WS_HB8) + (size_t)m2 * 1024, lane); }
    }
    SEAM(0);
#pragma unroll 1
    for (int l = 0; l < DEPTH; ++l) {
        const int pb = 1 + 11 * l;
        if (EN(0) && IN(pb + 0)) {
            KArgs a = kargs();
            { InProjOrder S; S.init((const bf16_t*)(a->ws + WS_HB8), (const bf16_t*)(a->ws + WS_WIN + (size_t)l * NCOL * 1024), T, NCOL - 1024, 512, G, (int)blockIdx.x);
              EpiInProj E{a->ws, a->in[I_BG] + l * 2048};
              pg8::gemm_phase<EpiInProj, InProjOrder, true>(lds, lds + XOFF_LDS, 512, S, E); }
            { KArgs a2 = kargs();
              pg8::DenseOrder S; S.init((const bf16_t*)(a2->ws + WS_WIN + ((size_t)l * NCOL + 2048) * 1024), (const bf16_t*)(a2->ws + WS_HB8), 1024, T, 512, G, (int)blockIdx.x);
              EpiVT E{(unsigned char*)(a2->ws + WS_VA)};
              pg8::gemm_phase<EpiVT, pg8::DenseOrder, true>(lds, lds + XOFF_LDS, 512, S, E); }
        }
        SEAM(pb + 0);
        if (EN(1) && IN(pb + 1)) {
            PH_IDS
            float lam;
            { const float q1 = a->in[I_LQ1][l * 64 + lane] * a->in[I_LK1][l * 64 + lane], q2 = a->in[I_LQ2][l * 64 + lane] * a->in[I_LK2][l * 64 + lane];
              lam = expf(wave_sum(q1)) - expf(wave_sum(q2)) + (0.8f - 0.6f * expf(-0.3f * (float)l));
              lam = __uint_as_float((unsigned)__builtin_amdgcn_readfirstlane((int)__float_as_uint(lam))); }
            { const float* rp = a->in[I_RPB] + (size_t)l * 16 * 465; LAS float* rl = (LAS float*)(lds + NA_RPB_OFF);
              for (int i = tid; i < 16 * 465; i += NWAVES * 64) rl[i] = rp[i] * LOG2E;
              if (tid < 256) ((LAS float*)(lds + NA_NINF_OFF))[tid] = -INFINITY; }
            LAS float* scr = (LAS float*)(lds + NA_SCR_OFF + wave * 8448);
            int k = 0;
            constexpr int NA_UNITS = BATCH * 32 * 16 * 2;
            for (int i = 0;; ++i) { const int L = i * G + (int)blockIdx.x; const bool hasu = L < BATCH * 8 * 8;
                if (hasu) { const int c = L & 255;
                    diffattn_unit(a, l, (c & 7) + 8 * (c >> 6), L >> 8, (c >> 3) & 7, lam, lds, tid);
                    __syncthreads(); }
                for (int j = 0; hasu ? j < 2 : true; ++j) {
                    const int u = gw + k * ngw, it = gw + 3 * k * ngw; if (u >= NA_UNITS && it >= N_EXP_ITEMS) break;
                    ++k;
                    KArgs a2 = kargs(); int lane2 = lane; asm volatile("" : "+v"(lane2));
                    if (u < NA_UNITS) na_wave_unit(a2, u, lds, wave, lane2);
                    convert_expert_items3(a2, l, it, it + ngw, it + 2 * ngw, scr, lane2); }
                if (!hasu) break;
                __syncthreads();
            }
        }
        SEAM(pb + 1);
        if (EN(2) && IN(pb + 2)) {
            { KArgs a = kargs();
              pg8::DenseOrder S; S.init((const bf16_t*)(a->ws + WS_OA8), (const bf16_t*)(a->ws + WS_WPA + (size_t)l * 1024 * 1024), T, 1024, 512, G, (int)blockIdx.x);
              EpiProj<false> E{(bf16_t*)(a->ws + WS_U), (const unsigned char*)(a->ws + WS_GA), nullptr, W8_INV / (OA8_SCALE * G8_SCALE)};
              pg8::gemm_phase<EpiProj<false>, pg8::DenseOrder, true>(lds, lds + XOFF_LDS, 512, S, E); }
            { KArgs a = kargs();
              pg8::DenseOrder S; S.init((const bf16_t*)(a->ws + WS_OB8), (const bf16_t*)(a->ws + WS_WPB + (size_t)l * 1024 * 512), T, 1024, 256, G, (int)blockIdx.x);
              EpiProj<true> E{(bf16_t*)(a->ws + WS_U), (const unsigned char*)(a->ws + WS_GB), (unsigned char*)(a->ws + WS_U8), W8_INV / (OB8_SCALE * G8_SCALE)};
              pg8::gemm_phase<EpiProj<true>, pg8::DenseOrder, true>(lds, lds + XOFF_LDS, 256, S, E); }
        }
        SEAM(pb + 2);
        if (EN(3) && IN(pb + 3)) {
            KArgs a = kargs();
            pg8::DenseOrder S; S.init((const bf16_t*)(a->ws + WS_U8), (const bf16_t*)(a->ws + WS_WOUT + (size_t)l * 1024 * 1024), T, 1024, 512, G, (int)blockIdx.x);
            EpiFp8Plain E{(unsigned char*)(a->ws + WS_MIX), Y_SCALE * W8_INV / U8_SCALE};
            pg8::gemm_phase<EpiFp8Plain, pg8::DenseOrder, true>(lds, lds + XOFF_LDS, 512, S, E);
        }
        SEAM(pb + 3);
        if (EN(4) && IN(pb + 4)) {
            PH_IDS
            float* H = a->out; bf16_t* HB = (bf16_t*)(a->ws + WS_HB);
            for (int m = gw; m < T; m += 2 * ngw) { f32x4 v[4], w[4]; const int m2 = m + ngw < T ? m + ngw : m;
#pragma unroll
                for (int j = 0; j < 4; ++j) v[j] = ldbf4(HB + (size_t)m * 1024 + 4 * lane + 256 * j) * ALPHA + ldfp8x4((const unsigned char*)(a->ws + WS_MIX) + (size_t)m * 1024 + 4 * lane + 256 * j);
#pragma unroll
                for (int j = 0; j < 4; ++j) w[j] = ldbf4(HB + (size_t)m2 * 1024 + 4 * lane + 256 * j) * ALPHA + ldfp8x4((const unsigned char*)(a->ws + WS_MIX) + (size_t)m2 * 1024 + 4 * lane + 256 * j);
                ln_store(v, a->in[I_L1G] + l * 1024, a->in[I_L1B] + l * 1024, nullptr, HB + (size_t)m * 1024, (unsigned char*)(a->ws + WS_HB8) + (size_t)m * 1024, lane);
                ln_store(w, a->in[I_L1G] + l * 1024, a->in[I_L1B] + l * 1024, nullptr, HB + (size_t)m2 * 1024, (unsigned char*)(a->ws + WS_HB8) + (size_t)m2 * 1024, lane); }
        }
        SEAM(pb + 4);
        if (EN(5) && IN(pb + 5)) {
            KArgs a = kargs();
            pg8::DenseOrder S; S.init((const bf16_t*)(a->ws + WS_HB), (const bf16_t*)(a->ws + WS_WR) + (size_t)l * 256 * 1024, T, 256, 1024, G, (int)blockIdx.x);
            EpiF32T E{(float*)(a->ws + WS_LOGIT), T};
            pg8::gemm_phase(lds, lds + XOFF_LDS, 1024, S, E);
        }
        SEAM(pb + 5);
        if (EN(6) && IN(pb + 6)) { KArgs a = kargs(); route_phase(a, l, lds, G); }
        SEAM(pb + 6);
        if (EN(7) && IN(pb + 7)) { KArgs a = kargs(); build_table((unsigned*)(a->ws + WS_CTL) + CW_CNT + l * 256, lds); slot_phase(a, l, lds, G); }
        SEAM(pb + 7);
        if (EN(8) && IN(pb + 8)) {
            KArgs a = kargs();
            build_table((unsigned*)(a->ws + WS_CTL) + CW_CNT + l * 256, lds);
            const LAS int* tab = (const LAS int*)(lds + TAB_OFF);
            ExpertOrderGU S{tab, (const bf16_t*)(a->ws + WS_HB8), (const bf16_t*)(a->ws + WS_EGU), (const int*)(a->ws + WS_STOK), G, (int)blockIdx.x, tab[257] * 2};
            EpiSwiglu E{(unsigned char*)(a->ws + WS_HMID)};
            pg8::gemm_phase<EpiSwiglu, ExpertOrderGU, true>(lds, lds + XOFF_LDS, 512, S, E);
        }
        SEAM(pb + 8);
        if (EN(9) && IN(pb + 9)) {
#ifndef NO9A
            { KArgs a = kargs();
              build_table((unsigned*)(a->ws + WS_CTL) + CW_CNT + l * 256, lds);
              const LAS int* tab = (const LAS int*)(lds + TAB_OFF);
              ExpertOrderDown S{tab, (const bf16_t*)(a->ws + WS_HMID), (const bf16_t*)(a->ws + WS_ED), G, (int)blockIdx.x, tab[256] * 4};
              EpiDown E{(unsigned char*)(a->ws + WS_Y), (const u32x2*)(a->ws + WS_SDST)};
              pg8::gemm_phase<EpiDown, ExpertOrderDown, true>(lds, lds + XOFF_LDS, 128, S, E); }
#endif
#ifndef NO9B
            { KArgs a = kargs();
              const LAS int* tab = (const LAS int*)(lds + TAB_OFF);
              pg8::DenseOrder S; S.init((const bf16_t*)(a->ws + WS_HMID + (size_t)tab[256] * 256 * 256), (const bf16_t*)(a->ws + WS_ED + (size_t)256 * 1024 * 256), T, 1024, 128, G, (int)blockIdx.x);
              EpiFp8Plain E{(unsigned char*)(a->ws + WS_YSH), Y_SCALE * W8_INV / H8_SCALE};
              pg8::gemm_phase<EpiFp8Plain, pg8::DenseOrder, true>(lds, lds + XOFF_LDS, 128, S, E); }
#endif
        }
        SEAM(pb + 9);
        if (EN(10) && IN(pb + 10)) {
            PH_IDS
            float* H = a->out; bf16_t* HB = (bf16_t*)(a->ws + WS_HB);
            const unsigned char* Y = (const unsigned char*)(a->ws + WS_Y);
            for (int m = gw; m < T; m += ngw) { f32x4 v[4];
#pragma unroll
                for (int j = 0; j < 4; ++j) v[j] = ldbf4(HB + (size_t)m * 1024 + 4 * lane + 256 * j) * ALPHA + ldfp8x4((const unsigned char*)(a->ws + WS_YSH) + (size_t)m * 1024 + 4 * lane + 256 * j);
                f32x4 ys[4] = {};
#pragma unroll
                for (int k = 0; k < 8; ++k)
#pragma unroll
                    for (int j = 0; j < 4; ++j) { const int y = __builtin_nontemporal_load((const int*)(Y + ((size_t)m * 8 + k) * 1024 + 4 * lane + 256 * j));
                        const f32x2 lo = __builtin_amdgcn_cvt_pk_f32_fp8(y, false), hi2 = __builtin_amdgcn_cvt_pk_f32_fp8(y, true);
                        ys[j].x += lo.x; ys[j].y += lo.y; ys[j].z += hi2.x; ys[j].w += hi2.y; }
#pragma unroll
                for (int j = 0; j < 4; ++j) v[j] = v[j] + ys[j] * (1.0f / Y_SCALE);
                ln_store(v, a->in[I_L2G] + l * 1024, a->in[I_L2B] + l * 1024, (l + 1 < DEPTH) ? nullptr : H + (size_t)m * 1024, (l + 1 < DEPTH) ? HB + (size_t)m * 1024 : nullptr, (l + 1 < DEPTH) ? (unsigned char*)(a->ws + WS_HB8) + (size_t)m * 1024 : nullptr, lane); }
        }
        SEAM(pb + 10);
    }
#undef IN
#undef SEAM
}

extern "C" void kernel_launch(void* const* d_in, const int* in_sizes, int n_in, void* d_out, int out_size, void* d_ws, size_t ws_size, hipStream_t stream) {
    static int grid = 0;
    if (grid == 0) {
        if (n_in != 26 || out_size != T * 1024 || ws_size < WS_END) { fprintf(stderr, "kernel_launch: unexpected shapes / workspace (n_in %d out %d ws %zu, need %zu)\n", n_in, out_size, ws_size, (size_t)WS_END); grid = -1; return; }
        int dev = 0, cus = 0, per_cu = 0;
        if (hipGetDevice(&dev) != hipSuccess || hipDeviceGetAttribute(&cus, hipDeviceAttributeMultiprocessorCount, dev) != hipSuccess) { grid = -1; return; }
        if (hipFuncSetAttribute((const void*)mega_fwd, hipFuncAttributeMaxDynamicSharedMemorySize, LDS_BYTES) != hipSuccess) { grid = -1; return; }
        if (hipOccupancyMaxActiveBlocksPerMultiprocessor(&per_cu, (const void*)mega_fwd, NWAVES * 64, LDS_BYTES) != hipSuccess || per_cu < 1) { fprintf(stderr, "kernel_launch: occupancy query says %d\n", per_cu); }
        (void)hipGetLastError();
        grid = cus;
    }
    if (grid < 0) return;
    (void)hipMemsetAsync((char*)d_ws + WS_CTL, 0, CTL_ZERO_BYTES, stream);
    Args a{};
    for (int i = 0; i < 26; ++i) a.in[i] = (const float*)d_in[i];
    a.out = (float*)d_out; a.ws = (unsigned char*)d_ws;
#if MK_ONE_LAUNCH
    a.ph_lo = 0; a.ph_hi = NPHASE;
    hipLaunchKernelGGL(mega_fwd, dim3(grid), dim3(NWAVES * 64), LDS_BYTES, stream, a);
#else
    for (int p = 0; p < NPHASE; ++p) { a.ph_lo = p; a.ph_hi = p + 1; hipLaunchKernelGGL(mega_fwd, dim3(grid), dim3(NWAVES * 64), LDS_BYTES, stream, a); }
#endif
}
```

```cpp
#include <hip/hip_runtime.h>
#include <cstdio>
#include <cstdint>

#ifndef MK_ONE_LAUNCH
#define MK_ONE_LAUNCH 1
#endif

#define LAS __attribute__((address_space(3)))
#define GAS __attribute__((address_space(1)))
typedef unsigned short bf16_t;
typedef short bf16x8 __attribute__((ext_vector_type(8)));
typedef short s16x4 __attribute__((ext_vector_type(4)));
typedef float f32x4 __attribute__((ext_vector_type(4)));
typedef float f32x2 __attribute__((ext_vector_type(2)));
typedef float f32x16 __attribute__((ext_vector_type(16)));
typedef unsigned u32x4 __attribute__((ext_vector_type(4)));
typedef unsigned u32x2 __attribute__((ext_vector_type(2)));

constexpr int BATCH = 32, SEQ = 2048, DM = 1024, T = BATCH * SEQ, DEPTH = 2;
constexpr int NCOL = 6656;
constexpr int NEXP = 256, TOPK = 8, EDIM = 256, NEXPS = NEXP + 1;
constexpr float LN_EPS = 1e-5f;
constexpr float ALPHA = 1.4142135623730951f;
constexpr float LOG2E = 1.4426950408889634f;
constexpr float ROUTE_SCALE = 2.5f;
constexpr int NSLOT_MAX = T * TOPK + NEXP * 256;
constexpr int NSLOT_ALL = NSLOT_MAX + T;

constexpr size_t MiB = 1u << 20;
constexpr size_t WS_CTL = 0, CTL_ZERO_BYTES = 1 * MiB;
constexpr size_t WS_WIN = 2 * MiB;
constexpr size_t WS_WPA = 28 * MiB;
constexpr size_t WS_WPB = 32 * MiB;
constexpr size_t WS_WOUT = 34 * MiB;
constexpr size_t WS_WR = 38 * MiB;
constexpr size_t WS_REIDX = 40 * MiB;
constexpr size_t WS_RPOS = 42 * MiB;
constexpr size_t WS_RW = 44 * MiB;
constexpr size_t WS_STOK = 46 * MiB;
constexpr size_t WS_SDST = 49 * MiB;
constexpr size_t WS_SW = 52 * MiB;
constexpr size_t WS_LOGIT = 56 * MiB;
constexpr size_t WS_HB = 120 * MiB;
constexpr size_t WS_EGU = 248 * MiB;
constexpr size_t WS_ED = 505 * MiB;
constexpr size_t WS_BIG = 636 * MiB;
constexpr size_t WS_QA = WS_BIG, WS_KA = WS_BIG + 128 * MiB, WS_VA = WS_BIG + 256 * MiB;
constexpr size_t WS_QN = WS_BIG + 384 * MiB, WS_KN = WS_BIG + 448 * MiB, WS_VN = WS_BIG + 512 * MiB;
constexpr size_t WS_GA = WS_BIG + 576 * MiB, WS_GB = WS_BIG + 704 * MiB;
constexpr size_t WS_MIX = WS_QA;
constexpr size_t WS_YSH = WS_EGU;
constexpr size_t WS_OA8 = WS_BIG + 832 * MiB, WS_OB8 = WS_BIG + 896 * MiB, WS_U8 = WS_BIG + 928 * MiB;
constexpr size_t WS_U = WS_KA;
constexpr size_t WS_HMID = WS_BIG;
constexpr size_t WS_Y = WS_BIG + 320 * MiB;
constexpr size_t WS_HB8 = WS_Y + 1024 * MiB;
constexpr size_t WS_END = WS_HB8 + 64 * MiB;
static_assert((size_t)NSLOT_ALL * 512 <= 320 * MiB, "hmid");
static_assert((size_t)NSLOT_MAX * 4 <= 3 * MiB, "slots");
constexpr int CW_TMO = 0;
constexpr int CW_BAR = 4096;
constexpr int CW_CNT = 16384;
constexpr int CW_ERR = 20000;

constexpr int RING_BYTES = 131072;
constexpr int MISC_OFF = RING_BYTES;
constexpr int TAB_OFF = MISC_OFF + 1024;
constexpr int XOFF_LDS = RING_BYTES + 8192;
constexpr int LDS_BYTES = 147456;

__device__ __forceinline__ unsigned f2bf(float f) { unsigned u = __builtin_bit_cast(unsigned, f); return (u + 0x7fffu + ((u >> 16) & 1u)) >> 16; }
__device__ __forceinline__ unsigned pk2(float lo, float hi) { return f2bf(lo) | (f2bf(hi) << 16); }
__device__ __forceinline__ float bf2f(unsigned short b) { return __builtin_bit_cast(float, (unsigned)b << 16); }
__device__ __forceinline__ float bflo(unsigned w) { return __builtin_bit_cast(float, w << 16); }
__device__ __forceinline__ float bfhi(unsigned w) { return __builtin_bit_cast(float, w & 0xffff0000u); }
typedef __bf16 bf16x2_t __attribute__((ext_vector_type(2)));
typedef int i32x4 __attribute__((ext_vector_type(4)));
typedef int i32x8 __attribute__((ext_vector_type(8)));
__device__ __forceinline__ unsigned cvt_pk_bf16(float lo, float hi) { const f32x2 v = {lo, hi}; const bf16x2_t b = __builtin_convertvector(v, bf16x2_t); return __builtin_bit_cast(unsigned, b); }
__device__ __forceinline__ float fast_sigmoid(float x) { return __builtin_amdgcn_rcpf(1.0f + __builtin_amdgcn_exp2f(-x * LOG2E)); }

namespace pg8 {
constexpr int BM = 256, BK = 64, HALF = 128, HTB = HALF * BK * 2, STAGE_BYTES = 8 * HTB, NXCD = 8, WGM = 8;
__host__ __device__ __forceinline__ int lds_byte(int r, int c) { const int st = (r >> 4) * 2 + (c >> 5), rr = r & 15, cc = c & 31, ob = rr * 64 + cc * 2; return st * 1024 + (ob ^ (((ob >> 9) & 1) << 5)); }
__host__ __device__ __forceinline__ void stage_rc(int b, int& R, int& C) { const int st = b / 1024, sb = b % 1024, swz = sb ^ (((sb >> 9) & 1) << 5); R = (st >> 1) * 16 + swz / 64; C = (st & 1) * 32 + (swz % 64) / 2; }
__host__ __device__ __forceinline__ int perm32(int rho) { const int n = rho >> 4, i = rho & 15; return 8 * (i >> 2) + 4 * n + (i & 3); }

struct Unit { int pm, pn, e, row0; };

struct DenseOrder {
    static constexpr bool GATHER = false;
    int nM, nN, nwg, G, c; const bf16_t* A; const bf16_t* Bt; int K;
    __device__ void init(const bf16_t* A_, const bf16_t* Bt_, int M, int N, int K_, int G_, int c_) { A = A_; Bt = Bt_; K = K_; nM = M / BM; nN = N / BM; nwg = nM * nN; G = G_; c = c_; }
    __device__ __forceinline__ bool next(int i, Unit& u) const {
        const long L = (long)i * G + c; if (L >= nwg) return false;
        int wgid = (int)L; { const int q = nwg / NXCD, r = nwg % NXCD, xcd = wgid % NXCD, off = wgid / NXCD; wgid = (xcd < r ? xcd * (q + 1) : r * (q + 1) + (xcd - r) * q) + off; }
        const int nig = WGM * nN, gid = wgid / nig, fm = gid * WGM, gsz = (nM - fm) < WGM ? (nM - fm) : WGM;
        u.pm = fm + ((wgid % nig) % gsz); u.pn = (wgid % nig) / gsz; u.e = 0; u.row0 = u.pm * BM; return true;
    }
    __device__ __forceinline__ const char* a_base() const { return (const char*)A; }
    __device__ __forceinline__ unsigned a_row(const Unit& u, int r) const { return (unsigned)(u.row0 + r); }
    __device__ __forceinline__ const char* b_tile(const Unit& u) const { return (const char*)Bt + (size_t)u.pn * BM * K * 2; }
};

template <class E, class = void> struct epi_has_prefetch { static constexpr bool value = false; };
template <class E> struct epi_has_prefetch<E, decltype((void)E::PREFETCH)> { static constexpr bool value = true; };
template <class Epi, class Sched, bool F8 = false>
__device__ __forceinline__ void gemm_phase(LAS unsigned char* lds, LAS unsigned char* xlds, const int K, const Sched& S, const Epi& E) {
    constexpr bool GATHER = Sched::GATHER;
    int tid_ = threadIdx.x; asm volatile("" : "+v"(tid_));
    const int tid = tid_, wid = __builtin_amdgcn_readfirstlane(tid >> 6), lane = tid & 63, wr = wid >> 2, wc = wid & 3, fr = lane & 15, fq = lane >> 4;
    const int nt = K / BK;
    unsigned voffA[2], voffB[2];
#pragma unroll
    for (int i = 0; i < 2; ++i) { int R, C; stage_rc(tid * 16 + i * 8192, R, C); const int Rb = Epi::WIDE16 ? (64 * (R >> 5) + 16 * ((R & 15) >> 2) + 4 * ((R >> 4) & 1) + (R & 3)) : (Epi::PERM ? ((R & ~31) + perm32(R & 31)) : R);
        voffA[i] = (unsigned)(R * K + C) * 2u; voffB[i] = (unsigned)(Rb * K + C) * 2u; }
    const size_t kstep = (size_t)(BK * 2);
    const size_t hstep = (size_t)HALF * K * 2;
    const size_t bhs = Epi::WIDE16 ? (size_t)8 * K * 2 : hstep;
    const unsigned rowb = (unsigned)K * 2u;
    const unsigned ldsw = (unsigned)wid * 1024u;
    const int aoff = lds_byte(wr * 64 + fr, fq * 8), boff = lds_byte(wc * 32 + fr, fq * 8);
    LAS u32x4* myx = (LAS u32x4*)(xlds + tid * 16);
#define PG8_SA(b, h) (((b) * 2 + (h)) * HTB)
#define PG8_SB(b, h) ((4 + (b) * 2 + (h)) * HTB)
#define PG8_STAGE(bufoff, gbase, voff) do { _Pragma("unroll") for (int _i = 0; _i < 2; ++_i) \
        __builtin_amdgcn_global_load_lds((const unsigned*)((const char*)(gbase) + (voff)[_i]), (LAS unsigned*)(lds + (bufoff) + ldsw + _i * 8192), 16, 0, 0); } while (0)
#define PG8_STAGE_A(bufoff, dbase, gkt, vv, h) do { if constexpr (GATHER) { PG8_STAGE(bufoff, gkt, (vv)[h]); } else { PG8_STAGE(bufoff, (dbase) + (h) * hstep, voffA); } } while (0)
#define PG8_LD8(p) __builtin_shufflevector(*(const LAS i32x4*)(p), *(const LAS i32x4*)((p) + 1024), 0, 1, 2, 3, 4, 5, 6, 7)
#define PG8_LDA(dst, b, h) do { _Pragma("unroll") for (int m = 0; m < 4; ++m) dst[m] = PG8_LD8(lds + PG8_SA(b, h) + aoff + m * 2048); } while (0)
#define PG8_LDB(dst, b, h) do { _Pragma("unroll") for (int n = 0; n < 2; ++n) dst[n] = PG8_LD8(lds + PG8_SB(b, h) + boff + n * 2048); } while (0)
#define PG8_LO(v) __builtin_bit_cast(bf16x8, __builtin_shufflevector(v, v, 0, 1, 2, 3))
#define PG8_HI(v) __builtin_bit_cast(bf16x8, __builtin_shufflevector(v, v, 4, 5, 6, 7))
#define PG8_MMA(ai, bj, At, Bt) do { __builtin_amdgcn_s_setprio(1); _Pragma("unroll") for (int m = 0; m < 4; ++m) _Pragma("unroll") for (int n = 0; n < 2; ++n) { \
        if constexpr (F8) asm volatile("v_mfma_f32_16x16x128_f8f6f4 %0, %1, %2, %0" : "+v"(acc[ai][bj][m][n]) : "v"(Bt[n]), "v"(At[m])); \
        else { acc[ai][bj][m][n] = __builtin_amdgcn_mfma_f32_16x16x32_bf16(PG8_LO(Bt[n]), PG8_LO(At[m]), acc[ai][bj][m][n], 0, 0, 0); \
               acc[ai][bj][m][n] = __builtin_amdgcn_mfma_f32_16x16x32_bf16(PG8_HI(Bt[n]), PG8_HI(At[m]), acc[ai][bj][m][n], 0, 0, 0); } } __builtin_amdgcn_s_setprio(0); } while (0)
#define PG8_WAIT_V(n) asm volatile("s_waitcnt vmcnt(" #n ")" ::: "memory")
#define PG8_WAIT_L(n) asm volatile("s_waitcnt lgkmcnt(" #n ")" ::: "memory")
#define PG8_BAR __builtin_amdgcn_s_barrier()
#define PG8_SCHED __builtin_amdgcn_sched_barrier(0)
    Unit cur, nxt; int ui = 0;
    if (!S.next(0, cur)) return;
    f32x4 acc[2][2][4][2];
#pragma unroll
    for (int a = 0; a < 2; ++a)
#pragma unroll
        for (int b = 0; b < 2; ++b)
#pragma unroll
            for (int m = 0; m < 4; ++m)
#pragma unroll
                for (int n = 0; n < 2; ++n) acc[a][b][m][n] = (f32x4){0.f, 0.f, 0.f, 0.f};
    i32x8 At[4], B0[2], B1[2];
    const char* const Abase = S.a_base();
    unsigned vc[2][2];
    if constexpr (GATHER) {
#pragma unroll
        for (int h = 0; h < 2; ++h)
#pragma unroll
            for (int i = 0; i < 2; ++i) { int R, C; stage_rc(tid * 16 + i * 8192, R, C); vc[h][i] = S.a_row(cur, h * HALF + R) * rowb + (unsigned)(C * 2); }
    } else { vc[0][0] = vc[0][1] = vc[1][0] = vc[1][1] = 0u; }
    const char* cA = GATHER ? Abase : Abase + (size_t)cur.row0 * rowb;
    const char* cB = S.b_tile(cur);
    PG8_STAGE(PG8_SB(0, 0), cB, voffB); PG8_STAGE(PG8_SB(0, 1), cB + bhs, voffB); PG8_STAGE_A(PG8_SA(0, 0), cA, Abase, vc, 0); PG8_STAGE_A(PG8_SA(0, 1), cA, Abase, vc, 1);
    if (wr == 1) PG8_BAR;
    PG8_WAIT_V(2); PG8_BAR;
    PG8_STAGE(PG8_SB(1, 0), cB + kstep, voffB); PG8_STAGE_A(PG8_SA(1, 0), cA + kstep, Abase + kstep, vc, 0); PG8_STAGE(PG8_SB(1, 1), cB + bhs + kstep, voffB);
    PG8_WAIT_V(6); PG8_BAR;
    for (;;) {
        const bool has_next = S.next(ui + 1, nxt);
        const char* nA = cA; const char* nB = cB;
        if (has_next) { nB = S.b_tile(nxt); if constexpr (!GATHER) nA = Abase + (size_t)nxt.row0 * rowb; }
        if constexpr (GATHER) {
            if (has_next) S.prefetch_rows(nxt, xlds + 4096 + ((ui + 1) & 1) * 2048, tid, wid);
        }
        if constexpr (epi_has_prefetch<Epi>::value) E.prefetch(cur, xlds + (ui & 1) * 2048, tid, wid);
#pragma unroll 1
        for (int t = 0; t < nt; t += 2) {
            const bool last = (t == nt - 2);
            const char* a1 = (GATHER ? Abase : cA) + (size_t)(t + 1) * kstep;
            const char* a2 = last ? (GATHER ? Abase : nA) : (GATHER ? Abase : cA) + (size_t)(t + 2) * kstep; const char* b2 = last ? nB : cB + (size_t)(t + 2) * kstep;
            const char* a3 = a2 + kstep; const char* b3 = b2 + kstep;
            unsigned v2[2][2];
            if constexpr (GATHER) {
                if (last && has_next) { const LAS unsigned char* xb = xlds + 4096 + ((ui + 1) & 1) * 2048; int R0, C0, R1, C1; stage_rc(tid * 16, R0, C0); stage_rc(tid * 16 + 8192, R1, C1);
                    v2[0][0] = S.a_row_lds(nxt, R0, xb) * rowb + (unsigned)(C0 * 2); v2[0][1] = S.a_row_lds(nxt, R1, xb) * rowb + (unsigned)(C1 * 2);
                    v2[1][0] = S.a_row_lds(nxt, HALF + R0, xb) * rowb + (unsigned)(C0 * 2); v2[1][1] = S.a_row_lds(nxt, HALF + R1, xb) * rowb + (unsigned)(C1 * 2); }
                else { v2[0][0] = vc[0][0]; v2[0][1] = vc[0][1]; v2[1][0] = vc[1][0]; v2[1][1] = vc[1][1]; }
            } else { v2[0][0] = v2[0][1] = v2[1][0] = v2[1][1] = 0u; }
            PG8_LDB(B0, 0, 0); PG8_LDB(B1, 0, 1); PG8_SCHED; PG8_LDA(At, 0, 0); PG8_STAGE_A(PG8_SA(1, 1), a1, a1, vc, 1);
            PG8_WAIT_V(8); PG8_WAIT_L(0); PG8_BAR; PG8_MMA(0, 0, At, B0); PG8_MMA(0, 1, At, B1); PG8_BAR; PG8_SCHED;
            PG8_LDA(At, 0, 1); PG8_STAGE(PG8_SB(0, 0), b2, voffB); PG8_STAGE(PG8_SB(0, 1), b2 + bhs, voffB); PG8_STAGE_A(PG8_SA(0, 0), a2, a2, v2, 0);
            PG8_WAIT_V(8); PG8_WAIT_L(0); PG8_BAR; PG8_MMA(1, 0, At, B0); PG8_MMA(1, 1, At, B1); PG8_BAR; PG8_SCHED;
            PG8_LDB(B0, 1, 0); PG8_LDB(B1, 1, 1); PG8_SCHED; PG8_LDA(At, 1, 0); PG8_STAGE_A(PG8_SA(0, 1), a2, a2, v2, 1);
            PG8_WAIT_V(8); PG8_WAIT_L(0); PG8_BAR; PG8_MMA(0, 0, At, B0); PG8_MMA(0, 1, At, B1); PG8_BAR; PG8_SCHED;
            PG8_LDA(At, 1, 1); PG8_STAGE(PG8_SB(1, 0), b3, voffB); PG8_STAGE(PG8_SB(1, 1), b3 + bhs, voffB); PG8_STAGE_A(PG8_SA(1, 0), a3, a3, v2, 0);
            PG8_WAIT_V(8); PG8_WAIT_L(0); PG8_BAR; PG8_MMA(1, 0, At, B0); PG8_MMA(1, 1, At, B1); PG8_BAR; PG8_SCHED;
            if constexpr (GATHER) { if (last) { vc[0][0] = v2[0][0]; vc[0][1] = v2[0][1]; vc[1][0] = v2[1][0]; vc[1][1] = v2[1][1]; } }
        }
        if constexpr (F8) asm volatile("s_nop 15\n\ts_nop 15" ::: "memory");
        if (wr == 0) PG8_BAR;
        if constexpr (epi_has_prefetch<Epi>::value) E(acc, cur, wr, wc, fr, fq, (const LAS unsigned char*)(xlds + (ui & 1) * 2048)); else E(acc, cur, wr, wc, fr, fq);
        if (!has_next) break;
#pragma unroll
        for (int a = 0; a < 2; ++a)
#pragma unroll
            for (int b = 0; b < 2; ++b)
#pragma unroll
                for (int m = 0; m < 4; ++m)
#pragma unroll
                    for (int n = 0; n < 2; ++n) acc[a][b][m][n] = (f32x4){0.f, 0.f, 0.f, 0.f};
        cur = nxt; cA = nA; cB = nB; ++ui;
        if (wr == 1) PG8_BAR;
    }
    PG8_WAIT_V(0);
    PG8_BAR;
#undef PG8_SA
#undef PG8_SB
#undef PG8_STAGE
#undef PG8_STAGE_A
#undef PG8_LDA
#undef PG8_LD8
#undef PG8_LO
#undef PG8_HI
#undef PG8_LDB
#undef PG8_MMA
#undef PG8_WAIT_V
#undef PG8_WAIT_L
#undef PG8_BAR
#undef PG8_SCHED
}
}

using pg8::Unit;
typedef const f32x4 (&AccRef)[2][2][4][2];
constexpr float W8_SCALE = 256.0f, W8_INV = 1.0f / 256.0f;
constexpr float OA8_SCALE = 8.0f, OB8_SCALE = 32.0f, U8_SCALE = 32.0f;
constexpr float QA8_SCALE = 4.0f;
constexpr float G8_SCALE = 256.0f;
constexpr float H8_SCALE = 8.0f;
constexpr float Y_SCALE = 32.0f;

struct EpiInProj {
    static constexpr bool PERM = true, WIDE16 = false;
    unsigned char* ws; const float* bgate;
    __device__ __forceinline__ void operator()(AccRef acc, const Unit& u, int wr, int wc, int fr, int fq) const {
        const int pn = u.pn; size_t off; int ldc, ct; float sc = W8_INV; int gate = -1;
        if (pn < 4) { off = WS_QA; ldc = 1024; ct = pn; sc = 0.125f * LOG2E * W8_INV * QA8_SCALE; }
        else if (pn < 8) { off = WS_KA; ldc = 1024; ct = pn - 4; sc = W8_INV / QA8_SCALE; }
        else if (pn < 12) { off = WS_VA; ldc = 1024; ct = pn - 8; }
        else if (pn < 14) { off = WS_QN; ldc = 512; ct = pn - 12; sc = 0.17677669529663687f * LOG2E * W8_INV; }
        else if (pn < 16) { off = WS_KN; ldc = 512; ct = pn - 14; }
        else if (pn < 18) { off = WS_VN; ldc = 512; ct = pn - 16; }
        else if (pn < 22) { off = WS_GA; ldc = 1024; ct = pn - 18; gate = 0; }
        else { off = WS_GB; ldc = 1024; ct = pn - 22; gate = 1; }
        bf16_t* base = (bf16_t*)(ws + off);
        const int row0 = u.pm * 256 + wr * 64 + fr, col0 = ct * 256 + wc * 32 + 8 * fq;
        if (gate >= 0) {
            f32x4 bv[2][2];
#pragma unroll
            for (int bj = 0; bj < 2; ++bj)
#pragma unroll
                for (int n = 0; n < 2; ++n) bv[bj][n] = *(const f32x4*)(bgate + gate * 1024 + col0 + bj * 128 + 4 * n);
#pragma unroll
            for (int ai = 0; ai < 2; ++ai)
#pragma unroll
                for (int m = 0; m < 4; ++m) { unsigned char* rowp8 = (unsigned char*)base + (size_t)(row0 + ai * 128 + m * 16) * 1024 + col0;
#pragma unroll
                    for (int bj = 0; bj < 2; ++bj) { f32x4 v0 = acc[ai][bj][m][0] * W8_INV + bv[bj][0], v1 = acc[ai][bj][m][1] * W8_INV + bv[bj][1];
#pragma unroll
                        for (int j = 0; j < 4; ++j) { v0[j] = fast_sigmoid(v0[j]) * G8_SCALE; v1[j] = fast_sigmoid(v1[j]) * G8_SCALE; }
                        int p0 = 0, p1 = 0;
                        p0 = __builtin_amdgcn_cvt_pk_fp8_f32(v0[0], v0[1], p0, false); p0 = __builtin_amdgcn_cvt_pk_fp8_f32(v0[2], v0[3], p0, true);
                        p1 = __builtin_amdgcn_cvt_pk_fp8_f32(v1[0], v1[1], p1, false); p1 = __builtin_amdgcn_cvt_pk_fp8_f32(v1[2], v1[3], p1, true);
                        u32x2 w; w.x = (unsigned)p0; w.y = (unsigned)p1; *(u32x2*)(rowp8 + bj * 128) = w; } }
        } else if (pn < 8) {
#pragma unroll
            for (int ai = 0; ai < 2; ++ai)
#pragma unroll
                for (int m = 0; m < 4; ++m) { unsigned char* rowp8 = (unsigned char*)base + (size_t)(row0 + ai * 128 + m * 16) * 1024 + col0;
#pragma unroll
                    for (int bj = 0; bj < 2; ++bj) { const f32x4 v0 = acc[ai][bj][m][0] * sc, v1 = acc[ai][bj][m][1] * sc;
                        int p0 = 0, p1 = 0;
                        p0 = __builtin_amdgcn_cvt_pk_fp8_f32(v0[0], v0[1], p0, false); p0 = __builtin_amdgcn_cvt_pk_fp8_f32(v0[2], v0[3], p0, true);
                        p1 = __builtin_amdgcn_cvt_pk_fp8_f32(v1[0], v1[1], p1, false); p1 = __builtin_amdgcn_cvt_pk_fp8_f32(v1[2], v1[3], p1, true);
                        u32x2 w; w.x = (unsigned)p0; w.y = (unsigned)p1; *(u32x2*)(rowp8 + bj * 128) = w; } }
        } else {
            const bool hm = pn >= 14; const int bjs = hm ? 262144 : 128;
#pragma unroll
            for (int ai = 0; ai < 2; ++ai)
#pragma unroll
                for (int m = 0; m < 4; ++m) { const int row = row0 + ai * 128 + m * 16;
                    bf16_t* rowp = hm ? base + (size_t)(row >> 11) * 1048576 + (size_t)(col0 >> 5) * 65536 + (row & 2047) * 32 + (col0 & 31) : base + (size_t)row * ldc + col0;
#pragma unroll
                    for (int bj = 0; bj < 2; ++bj) { const f32x4 v0 = acc[ai][bj][m][0] * sc, v1 = acc[ai][bj][m][1] * sc;
                        u32x4 w; w.x = cvt_pk_bf16(v0[0], v0[1]); w.y = cvt_pk_bf16(v0[2], v0[3]); w.z = cvt_pk_bf16(v1[0], v1[1]); w.w = cvt_pk_bf16(v1[2], v1[3]);
                        *(u32x4*)(rowp + bj * bjs) = w; } }
        }
    }
};

constexpr float V8_SCALE = 8.0f;
struct EpiVT {
    static constexpr bool PERM = true, WIDE16 = false;
    unsigned char* VT;
    __device__ __forceinline__ void operator()(AccRef acc, const Unit& u, int wr, int wc, int fr, int fq) const {
        const int d0 = u.pm * 256 + wr * 64 + fr, t0 = u.pn * 256 + wc * 32 + 8 * fq;
#pragma unroll
        for (int ai = 0; ai < 2; ++ai)
#pragma unroll
            for (int m = 0; m < 4; ++m) { const int dg = d0 + ai * 128 + m * 16;
#pragma unroll
                for (int bj = 0; bj < 2; ++bj) { const int t = t0 + bj * 128, bb = t >> 11, sq = t & 2047, t6 = sq & 63;
                    unsigned char* p = VT + ((size_t)((bb * 8 + (dg >> 7)) * 128 + (dg & 127)) * 2048) + (sq >> 6) * 64 + 16 * (t6 >> 5) + 4 * ((t6 & 31) >> 3);
                    const f32x4 v0 = acc[ai][bj][m][0] * (W8_INV * V8_SCALE), v1 = acc[ai][bj][m][1] * (W8_INV * V8_SCALE);
                    int p0 = 0, p1 = 0;
                    p0 = __builtin_amdgcn_cvt_pk_fp8_f32(v0[0], v0[1], p0, false); p0 = __builtin_amdgcn_cvt_pk_fp8_f32(v0[2], v0[3], p0, true);
                    p1 = __builtin_amdgcn_cvt_pk_fp8_f32(v1[0], v1[1], p1, false); p1 = __builtin_amdgcn_cvt_pk_fp8_f32(v1[2], v1[3], p1, true);
                    *(int*)p = p0; *(int*)(p + 32) = p1; } }
    }
};
struct InProjOrder : pg8::DenseOrder {
    __device__ __forceinline__ bool next(int i, Unit& u) const { if (!pg8::DenseOrder::next(i, u)) return false; if (u.pn >= 8) u.pn += 4; return true; }
};

template <bool ADD> struct EpiProj {
    static constexpr bool PERM = true, WIDE16 = false;
    bf16_t* U; const unsigned char* G; unsigned char* U8; float asc;
    __device__ __forceinline__ void operator()(AccRef acc, const Unit& u, int wr, int wc, int fr, int fq) const {
        const int row0 = u.pm * 256 + wr * 64 + fr, col0 = u.pn * 256 + wc * 32 + 8 * fq;
#pragma unroll
        for (int ai = 0; ai < 2; ++ai) {
            u32x2 g[4][2]; u32x4 o[4][2];
#pragma unroll
            for (int m = 0; m < 4; ++m)
#pragma unroll
                for (int bj = 0; bj < 2; ++bj) { const size_t ro = (size_t)(row0 + ai * 128 + m * 16) * 1024 + col0 + bj * 128; g[m][bj] = *(const u32x2*)(G + ro);
                    if (ADD) o[m][bj] = *(const u32x4*)(U + ro); }
#pragma unroll
            for (int m = 0; m < 4; ++m)
#pragma unroll
                for (int bj = 0; bj < 2; ++bj) { const size_t ro = (size_t)(row0 + ai * 128 + m * 16) * 1024 + col0 + bj * 128; const f32x4 v0 = acc[ai][bj][m][0] * asc, v1 = acc[ai][bj][m][1] * asc; const u32x2 gg = g[m][bj];
                    const f32x2 g0 = __builtin_amdgcn_cvt_pk_f32_fp8((int)gg.x, false), g1 = __builtin_amdgcn_cvt_pk_f32_fp8((int)gg.x, true), g2 = __builtin_amdgcn_cvt_pk_f32_fp8((int)gg.y, false), g3 = __builtin_amdgcn_cvt_pk_f32_fp8((int)gg.y, true);
                    float r[8];
                    r[0] = g0.x * v0[0]; r[1] = g0.y * v0[1]; r[2] = g1.x * v0[2]; r[3] = g1.y * v0[3];
                    r[4] = g2.x * v1[0]; r[5] = g2.y * v1[1]; r[6] = g3.x * v1[2]; r[7] = g3.y * v1[3];
                    if (ADD) { const u32x4 oo = o[m][bj];
                        r[0] += bflo(oo.x); r[1] += bfhi(oo.x); r[2] += bflo(oo.y); r[3] += bfhi(oo.y); r[4] += bflo(oo.z); r[5] += bfhi(oo.z); r[6] += bflo(oo.w); r[7] += bfhi(oo.w);
                        int p0 = 0, p1 = 0;
                        p0 = __builtin_amdgcn_cvt_pk_fp8_f32(r[0] * U8_SCALE, r[1] * U8_SCALE, p0, false); p0 = __builtin_amdgcn_cvt_pk_fp8_f32(r[2] * U8_SCALE, r[3] * U8_SCALE, p0, true);
                        p1 = __builtin_amdgcn_cvt_pk_fp8_f32(r[4] * U8_SCALE, r[5] * U8_SCALE, p1, false); p1 = __builtin_amdgcn_cvt_pk_fp8_f32(r[6] * U8_SCALE, r[7] * U8_SCALE, p1, true);
                        u32x2 w; w.x = (unsigned)p0; w.y = (unsigned)p1; *(u32x2*)(U8 + ro) = w; }
                    else { u32x4 w; w.x = cvt_pk_bf16(r[0], r[1]); w.y = cvt_pk_bf16(r[2], r[3]); w.z = cvt_pk_bf16(r[4], r[5]); w.w = cvt_pk_bf16(r[6], r[7]);
                        *(u32x4*)(U + ro) = w; } }
            asm volatile("" ::: "memory"); }
    }
};

struct EpiResid {
    static constexpr bool PERM = false, WIDE16 = false;
    float* H;
    __device__ __forceinline__ void operator()(AccRef acc, const Unit& u, int wr, int wc, int fr, int fq) const {
        const int row0 = u.row0 + wr * 64 + fr, col0 = u.pn * 256 + wc * 32 + 4 * fq;
#pragma unroll
        for (int ai = 0; ai < 2; ++ai)
#pragma unroll
            for (int m = 0; m < 4; ++m) { float* rowp = H + (size_t)(row0 + ai * 128 + m * 16) * 1024 + col0;
#pragma unroll
                for (int bj = 0; bj < 2; ++bj)
#pragma unroll
                    for (int n = 0; n < 2; ++n) { const f32x4 h = *(const f32x4*)(rowp + bj * 128 + n * 16); *(f32x4*)(rowp + bj * 128 + n * 16) = h * ALPHA + acc[ai][bj][m][n]; }
                asm volatile("" ::: "memory"); }
    }
};

struct EpiFp8Plain {
    static constexpr bool PERM = true, WIDE16 = true;
    unsigned char* O; float osc;
    __device__ __forceinline__ void operator()(AccRef acc, const Unit& u, int wr, int wc, int fr, int fq) const {
        const int row0 = u.row0 + wr * 64 + fr, col0 = u.pn * 256 + wc * 64 + 16 * fq;
#pragma unroll
        for (int ai = 0; ai < 2; ++ai)
#pragma unroll
            for (int m = 0; m < 4; ++m) { u32x4 w;
#pragma unroll
                for (int bj = 0; bj < 2; ++bj)
#pragma unroll
                    for (int n = 0; n < 2; ++n) { const f32x4 v = acc[ai][bj][m][n] * osc; int p = 0;
                        p = __builtin_amdgcn_cvt_pk_fp8_f32(v[0], v[1], p, false); p = __builtin_amdgcn_cvt_pk_fp8_f32(v[2], v[3], p, true); w[2 * bj + n] = (unsigned)p; }
                *(u32x4*)(O + (size_t)(row0 + ai * 128 + m * 16) * 1024 + col0) = w; }
    }
};

struct EpiF32 {
    static constexpr bool PERM = false, WIDE16 = false;
    float* C; int ldc;
    __device__ __forceinline__ void operator()(AccRef acc, const Unit& u, int wr, int wc, int fr, int fq) const {
        const int row0 = u.pm * 256 + wr * 64 + fr, col0 = u.pn * 256 + wc * 32 + 4 * fq;
#pragma unroll
        for (int ai = 0; ai < 2; ++ai)
#pragma unroll
            for (int m = 0; m < 4; ++m) { float* rowp = C + (size_t)(row0 + ai * 128 + m * 16) * ldc + col0;
#pragma unroll
                for (int bj = 0; bj < 2; ++bj)
#pragma unroll
                    for (int n = 0; n < 2; ++n) *(f32x4*)(rowp + bj * 128 + n * 16) = acc[ai][bj][m][n]; }
    }
};

struct EpiF32T {
    static constexpr bool PERM = false, WIDE16 = false;
    float* CT; int ldr;
    __device__ __forceinline__ void operator()(AccRef acc, const Unit& u, int wr, int wc, int fr, int fq) const {
        const int row0 = u.pm * 256 + wr * 64 + fr, col0 = u.pn * 256 + wc * 32 + 4 * fq;
#pragma unroll
        for (int ai = 0; ai < 2; ++ai)
#pragma unroll
            for (int m = 0; m < 4; ++m) { float* base = CT + (size_t)col0 * ldr + (row0 + ai * 128 + m * 16);
#pragma unroll
                for (int bj = 0; bj < 2; ++bj)
#pragma unroll
                    for (int n = 0; n < 2; ++n)
#pragma unroll
                        for (int j = 0; j < 4; ++j) base[(size_t)(bj * 128 + n * 16 + j) * ldr] = acc[ai][bj][m][n][j]; }
    }
};

struct EpiSwiglu {
    static constexpr bool PERM = true, WIDE16 = false;
    unsigned char* Hm;
    __device__ __forceinline__ void operator()(AccRef acc, const Unit& u, int wr, int wc, int fr, int fq) const {
        const int row0 = u.pm * 256 + wr * 64 + fr, col0 = u.pn * 128 + wc * 32 + 8 * fq;
#pragma unroll
        for (int ai = 0; ai < 2; ++ai)
#pragma unroll
            for (int m = 0; m < 4; ++m) { unsigned char* rowp = Hm + (size_t)(row0 + ai * 128 + m * 16) * 256 + col0;
                float r[8];
#pragma unroll
                for (int n = 0; n < 2; ++n)
#pragma unroll
                    for (int j = 0; j < 4; ++j) { const float g = acc[ai][0][m][n][j] * W8_INV, up = acc[ai][1][m][n][j] * (W8_INV * H8_SCALE); r[4 * n + j] = g * fast_sigmoid(g) * up; }
                int p0 = 0, p1 = 0;
                p0 = __builtin_amdgcn_cvt_pk_fp8_f32(r[0], r[1], p0, false); p0 = __builtin_amdgcn_cvt_pk_fp8_f32(r[2], r[3], p0, true);
                p1 = __builtin_amdgcn_cvt_pk_fp8_f32(r[4], r[5], p1, false); p1 = __builtin_amdgcn_cvt_pk_fp8_f32(r[6], r[7], p1, true);
                u32x2 w; w.x = (unsigned)p0; w.y = (unsigned)p1; *(u32x2*)rowp = w; }
    }
};

struct EpiDown {
    static constexpr bool PERM = true, WIDE16 = true, PREFETCH = true;
    unsigned char* Y; const u32x2* sinf;
    __device__ __forceinline__ void prefetch(const Unit& u, LAS unsigned char* buf, int tid, int wid) const {
        __builtin_amdgcn_global_load_lds((const unsigned*)(sinf + (size_t)u.pm * 256) + tid, (LAS unsigned*)(buf + wid * 256), 4, 0, 0);
    }
    __device__ __forceinline__ void operator()(AccRef acc, const Unit& u, int wr, int wc, int fr, int fq, const LAS unsigned char* buf) const {
        const int r0 = wr * 64 + fr, col0 = u.pn * 256 + wc * 64 + 16 * fq;
        int dst[8]; float wg[8];
#pragma unroll
        for (int i = 0; i < 8; ++i) { const u32x2 si = *(const LAS u32x2*)(buf + (r0 + (i >> 2) * 128 + (i & 3) * 16) * 8); const unsigned sx = si.x, sy = si.y; dst[i] = (int)sx; wg[i] = __uint_as_float(sy); }
#pragma unroll
        for (int ai = 0; ai < 2; ++ai)
#pragma unroll
            for (int m = 0; m < 4; ++m) { const int d = dst[ai * 4 + m]; const float wgt = wg[ai * 4 + m] * (Y_SCALE * W8_INV / H8_SCALE);
                if (d >= 0) { u32x4 w;
#pragma unroll
                    for (int bj = 0; bj < 2; ++bj)
#pragma unroll
                        for (int n = 0; n < 2; ++n) { const f32x4 v = acc[ai][bj][m][n] * wgt; int p = 0;
                            p = __builtin_amdgcn_cvt_pk_fp8_f32(v[0], v[1], p, false); p = __builtin_amdgcn_cvt_pk_fp8_f32(v[2], v[3], p, true); w[2 * bj + n] = (unsigned)p; }
                    *(u32x4*)(Y + (size_t)d * 1024 + col0) = w; } }
    }
};

__device__ __forceinline__ int tab_find(const LAS int* tab, int pm) {
    int lo = 0, hi = 256;
    while (lo < hi) { const int mid = (lo + hi + 1) >> 1; if (tab[mid] <= pm) lo = mid; else hi = mid - 1; }
    return lo;
}
__device__ __forceinline__ int xcd_remap(int L, int nwg) { const int q = nwg / 8, r = nwg % 8, xcd = L % 8, off = L / 8; return (xcd < r ? xcd * (q + 1) : r * (q + 1) + (xcd - r) * q) + off; }

struct ExpertOrderGU {
    static constexpr bool GATHER = true;
    const LAS int* tab; const bf16_t* A; const bf16_t* W; const int* stok; int G, c, nwg;
    __device__ __forceinline__ bool next(int i, Unit& u) const {
        const long L = (long)i * G + c; if (L >= nwg) return false;
        const int id = xcd_remap((int)L, nwg);
        u.pm = id >> 1; u.pn = id & 1; u.e = __builtin_amdgcn_readfirstlane(tab_find(tab, u.pm)); u.row0 = (u.pm - tab[256]) * 256; return true;
    }
    __device__ __forceinline__ const char* a_base() const { return (const char*)A; }
    __device__ __forceinline__ unsigned a_row(const Unit& u, int r) const { return u.e == 256 ? (unsigned)(u.row0 + r) : (unsigned)stok[u.pm * 256 + r]; }
    __device__ __forceinline__ void prefetch_rows(const Unit& u, LAS unsigned char* buf, int tid, int wid) const {
        if (u.e != 256) __builtin_amdgcn_global_load_lds((const unsigned*)(stok + (size_t)u.pm * 256) + (tid & 255), (LAS unsigned*)(buf + wid * 256), 4, 0, 0);
    }
    __device__ __forceinline__ unsigned a_row_lds(const Unit& u, int r, const LAS unsigned char* buf) const { return u.e == 256 ? (unsigned)(u.row0 + r) : ((const LAS unsigned*)buf)[r]; }
    __device__ __forceinline__ const char* b_tile(const Unit& u) const { return (const char*)W + ((size_t)u.e * 512 + (size_t)u.pn * 256) * 1024; }
};
struct ExpertOrderDown {
    static constexpr bool GATHER = false;
    const LAS int* tab; const bf16_t* A; const bf16_t* W; int G, c, nwg;
    __device__ __forceinline__ bool next(int i, Unit& u) const {
        const long L = (long)i * G + c; if (L >= nwg) return false;
        const int id = xcd_remap((int)L, nwg);
        u.pm = id >> 2; u.pn = id & 3; u.e = __builtin_amdgcn_readfirstlane(tab_find(tab, u.pm)); u.row0 = u.pm * 256; return true;
    }
    __device__ __forceinline__ const char* a_base() const { return (const char*)A; }
    __device__ __forceinline__ unsigned a_row(const Unit& u, int r) const { return (unsigned)(u.row0 + r); }
    __device__ __forceinline__ const char* b_tile(const Unit& u) const { return (const char*)W + ((size_t)u.e * 1024 + (size_t)u.pn * 256) * 256; }
};

#define XB_TMO      128
#define XB_XCNT(j)  (256  + 64 * (j))
#define XB_XSUB(j)  (1280 + 64 * (j))
#define XB_XGEN(j)  (2304 + 64 * (j))
#define XB_TOP      3328
#define XB_TOPGEN   3392
#define XCD_BAR_WORDS 3456
#define XB_SPIN_CAP (1u << 22)
__device__ __forceinline__ unsigned xb_ld(unsigned* p)              { return __hip_atomic_load(p, __ATOMIC_RELAXED, __HIP_MEMORY_SCOPE_AGENT); }
__device__ __forceinline__ unsigned xb_add(unsigned* p, unsigned v) { return __hip_atomic_fetch_add(p, v, __ATOMIC_RELAXED, __HIP_MEMORY_SCOPE_AGENT); }
__device__ __forceinline__ unsigned xb_xcc_id() { return (unsigned)__builtin_amdgcn_s_getreg((3 << 11) | 20) & 0xFu; }
#define XB_SPIN(cond, bar) do { unsigned _sp = 0; while (cond) { __builtin_amdgcn_s_sleep(1); \
    if ((++_sp & 255u) == 0u) { if (xb_ld(&(bar)[XB_TMO])) break; if (_sp > XB_SPIN_CAP) { atomicAdd(&(bar)[XB_TMO], 1u); break; } } } } while (0)
struct XcdBarrier { unsigned* bar; unsigned x; volatile LAS unsigned* st; };
__device__ __forceinline__ XcdBarrier xcd_barrier_post(unsigned* bar, volatile LAS unsigned* st) {
    XcdBarrier b; b.bar = bar; b.x = xb_xcc_id(); b.st = st;
    if (threadIdx.x == 0) (void)xb_add(&bar[XB_XCNT(b.x)], 1u);
    return b;
}
__device__ __forceinline__ void xcd_barrier_complete(unsigned* bar, unsigned x, unsigned& nloc, unsigned& nx) {
    const unsigned G = gridDim.x * gridDim.y * gridDim.z;
    unsigned sum, cnt, mine, sp = 0u;
    for (;;) {
        sum = 0u; cnt = 0u; mine = 0u;
#pragma unroll
        for (unsigned j = 0; j < 16; ++j) { const unsigned c = xb_ld(&bar[XB_XCNT(j)]); sum += c; cnt += (c > 0u) ? 1u : 0u; mine = (j == x) ? c : mine; }
        if (sum == G) break;
        __builtin_amdgcn_s_sleep(1);
        if ((++sp & 255u) == 0u) { if (xb_ld(&bar[XB_TMO])) break; if (sp > XB_SPIN_CAP) { atomicAdd(&bar[XB_TMO], 1u); break; } }
    }
    nloc = mine > 0u ? mine : 1u; nx = cnt > 0u ? cnt : 1u;
}
__device__ __forceinline__ void xcd_barrier(const XcdBarrier& b) {
    asm volatile("s_waitcnt vmcnt(0)" ::: "memory");
    __syncthreads();
    if (threadIdx.x == 0) {
        unsigned* bar = b.bar;
        __builtin_amdgcn_s_waitcnt(0);
        unsigned nloc = b.st[0], nx = b.st[1];
        if (nloc == 0u) { xcd_barrier_complete(bar, b.x, nloc, nx); b.st[0] = nloc; b.st[1] = nx; }
        const unsigned old = xb_add(&bar[XB_XSUB(b.x)], 1u);
        const unsigned gen = old / nloc;
        if (old + 1u == (gen + 1u) * nloc) {
            __builtin_amdgcn_fence(__ATOMIC_RELEASE, "agent");
            asm volatile("s_waitcnt vmcnt(0)" ::: "memory");
            const unsigned og = xb_add(&bar[XB_TOP], 1u);
            const unsigned tg = og / nx;
            if (og + 1u == (tg + 1u) * nx) xb_add(&bar[XB_TOPGEN], 1u);
            else XB_SPIN(xb_ld(&bar[XB_TOPGEN]) == tg, bar);
            __builtin_amdgcn_fence(__ATOMIC_ACQUIRE, "agent");
            xb_add(&bar[XB_XGEN(b.x)], 1u);
            asm volatile("s_waitcnt vmcnt(0)" ::: "memory");
        } else {
            XB_SPIN(xb_ld(&bar[XB_XGEN(b.x)]) == gen, bar);
            __builtin_amdgcn_fence(__ATOMIC_ACQUIRE, "agent");
            asm volatile("s_waitcnt vmcnt(0)" ::: "memory");
        }
    }
    __syncthreads();
}

struct Args { const float* in[26]; float* out; unsigned char* ws; int ph_lo, ph_hi; };
typedef const __attribute__((address_space(4))) Args* KArgs;
__device__ __forceinline__ KArgs kargs() { KArgs p = (KArgs)__builtin_amdgcn_kernarg_segment_ptr(); asm volatile("" : "+s"(p)); return p; }
enum { I_X = 0, I_EG, I_EB, I_WIN, I_BG, I_LQ1, I_LK1, I_LQ2, I_LK2, I_SUBG, I_WPA, I_RPB, I_WPB, I_WOUT, I_L1G, I_L1B, I_RW, I_RB, I_EWG, I_EWU, I_EWD, I_SWG, I_SWU, I_SWD, I_L2G, I_L2B };
constexpr int NWAVES = 8;

__device__ __forceinline__ float wave_sum(float v) {
#pragma unroll
    for (int o = 1; o < 64; o <<= 1) v += __shfl_xor(v, o);
    return v;
}

template <bool F8 = false>
__device__ __forceinline__ void transpose_item(const float* W, int N, int k0, int n0, bf16_t* dst, int Kd, int drow0, LAS float* scr, int lane) {
    float tv[32];
#pragma unroll
    for (int i = 0; i < 32; ++i) { const int kk = 2 * i + (lane >> 5); tv[i] = __builtin_nontemporal_load(W + (size_t)(k0 + kk) * N + n0 + (lane & 31)); }
#pragma unroll
    for (int i = 0; i < 32; ++i) { const int kk = 2 * i + (lane >> 5); scr[kk * 33 + (lane & 31)] = tv[i]; }
    asm volatile("s_waitcnt lgkmcnt(0)" ::: "memory");
    const int c = lane & 7;
#pragma unroll
    for (int j = 0; j < 4; ++j) { const int n = (lane >> 3) + 8 * j; const LAS float* s = scr + (8 * c) * 33 + n;
        if constexpr (F8) { int p0 = 0, p1 = 0;
            p0 = __builtin_amdgcn_cvt_pk_fp8_f32(s[0 * 33] * W8_SCALE, s[1 * 33] * W8_SCALE, p0, false); p0 = __builtin_amdgcn_cvt_pk_fp8_f32(s[2 * 33] * W8_SCALE, s[3 * 33] * W8_SCALE, p0, true);
            p1 = __builtin_amdgcn_cvt_pk_fp8_f32(s[4 * 33] * W8_SCALE, s[5 * 33] * W8_SCALE, p1, false); p1 = __builtin_amdgcn_cvt_pk_fp8_f32(s[6 * 33] * W8_SCALE, s[7 * 33] * W8_SCALE, p1, true);
            u32x2 o; o.x = (unsigned)p0; o.y = (unsigned)p1; *(u32x2*)((unsigned char*)dst + (size_t)(drow0 + n) * Kd + k0 + 8 * c) = o; }
        else { u32x4 o; o.x = pk2(s[0 * 33], s[1 * 33]); o.y = pk2(s[2 * 33], s[3 * 33]); o.z = pk2(s[4 * 33], s[5 * 33]); o.w = pk2(s[6 * 33], s[7 * 33]);
            *(u32x4*)(dst + (size_t)(drow0 + n) * Kd + k0 + 8 * c) = o; } }
    asm volatile("s_waitcnt lgkmcnt(0)" ::: "memory");
}

struct ConvItem { const float* W; unsigned char* dst; int N, k0, n0, Kd, drow0; bool valid; };
__device__ __forceinline__ void conv_load(const ConvItem& d, float (&tv)[32], int lane) {
#pragma unroll
    for (int i = 0; i < 32; ++i) { const int kk = 2 * i + (lane >> 5); tv[i] = __builtin_nontemporal_load(d.W + (size_t)(d.k0 + kk) * d.N + d.n0 + (lane & 31)); }
}
__device__ __forceinline__ void conv_store(const ConvItem& d, const float (&tv)[32], LAS float* scr, int lane) {
#pragma unroll
    for (int i = 0; i < 32; ++i) { const int kk = 2 * i + (lane >> 5); scr[kk * 33 + (lane & 31)] = tv[i]; }
    asm volatile("s_waitcnt lgkmcnt(0)" ::: "memory");
    const int c = lane & 7;
#pragma unroll
    for (int j = 0; j < 4; ++j) { const int n = (lane >> 3) + 8 * j; const LAS float* s = scr + (8 * c) * 33 + n; int p0 = 0, p1 = 0;
        p0 = __builtin_amdgcn_cvt_pk_fp8_f32(s[0 * 33] * W8_SCALE, s[1 * 33] * W8_SCALE, p0, false); p0 = __builtin_amdgcn_cvt_pk_fp8_f32(s[2 * 33] * W8_SCALE, s[3 * 33] * W8_SCALE, p0, true);
        p1 = __builtin_amdgcn_cvt_pk_fp8_f32(s[4 * 33] * W8_SCALE, s[5 * 33] * W8_SCALE, p1, false); p1 = __builtin_amdgcn_cvt_pk_fp8_f32(s[6 * 33] * W8_SCALE, s[7 * 33] * W8_SCALE, p1, true);
        u32x2 o; o.x = (unsigned)p0; o.y = (unsigned)p1; *(u32x2*)(d.dst + (size_t)(d.drow0 + n) * d.Kd + d.k0 + 8 * c) = o; }
    asm volatile("s_waitcnt lgkmcnt(0)" ::: "memory");
}

__device__ __forceinline__ void convert_small(KArgs a, LAS unsigned char* lds, int gw, int ngw, int lane, int wave) {
    LAS float* scr = (LAS float*)(lds + wave * 16384);
    constexpr int PER_L = 3328 + 512 + 256 + 512 + 128;
    for (int it = gw; it < 2 * PER_L; it += ngw) {
        const int l = it / PER_L; int r = it % PER_L;
        if (r < 3328) { const int kb = r / 208, nb = r % 208; transpose_item<true>(a->in[I_WIN] + (size_t)l * 1024 * NCOL, NCOL, 64 * kb, 32 * nb, (bf16_t*)(a->ws + WS_WIN + (size_t)l * NCOL * 1024), 1024, 32 * nb, scr, lane); continue; } r -= 3328;
        if (r < 512) { const int kb = r / 32, nb = r % 32; transpose_item<true>(a->in[I_WPA] + (size_t)l * 1024 * 1024, 1024, 64 * kb, 32 * nb, (bf16_t*)(a->ws + WS_WPA + (size_t)l * 1024 * 1024), 1024, 32 * nb, scr, lane); continue; } r -= 512;
        if (r < 256) { const int kb = r / 32, nb = r % 32; transpose_item<true>(a->in[I_WPB] + (size_t)l * 512 * 1024, 1024, 64 * kb, 32 * nb, (bf16_t*)(a->ws + WS_WPB + (size_t)l * 1024 * 512), 512, 32 * nb, scr, lane); continue; } r -= 256;
        if (r < 512) { const int kb = r / 32, nb = r % 32; transpose_item<true>(a->in[I_WOUT] + (size_t)l * 1024 * 1024, 1024, 64 * kb, 32 * nb, (bf16_t*)(a->ws + WS_WOUT + (size_t)l * 1024 * 1024), 1024, 32 * nb, scr, lane); continue; } r -= 512;
        { const int kb = r / 8, nb = r % 8; transpose_item(a->in[I_RW] + (size_t)l * 1024 * 256, 256, 64 * kb, 32 * nb, (bf16_t*)(a->ws + WS_WR) + (size_t)l * 256 * 1024, 1024, 32 * nb, scr, lane); }
    }
}
constexpr int N_EXP_ITEMS = 771 * 128;
__device__ __forceinline__ ConvItem expert_item(KArgs a, int l, int it) {
    ConvItem d; d.valid = it < N_EXP_ITEMS; if (!d.valid) it = 0;
    const int mat = it >> 7, sub = it & 127;
    if (mat < 512 || mat == 768 || mat == 769) {
        const bool up = (mat >= 256 && mat < 512) || mat == 769; const int e = mat < 256 ? mat : (mat < 512 ? mat - 256 : 256);
        d.W = mat < 256 ? a->in[I_EWG] + ((size_t)l * 256 + e) * 262144 : (mat < 512 ? a->in[I_EWU] + ((size_t)l * 256 + e) * 262144 : (mat == 768 ? a->in[I_SWG] + (size_t)l * 262144 : a->in[I_SWU] + (size_t)l * 262144));
        const int kb = sub >> 3, nb = sub & 7, n0 = 32 * nb;
        d.N = 256; d.k0 = 64 * kb; d.n0 = n0; d.dst = a->ws + WS_EGU + (size_t)e * 512 * 1024; d.Kd = 1024; d.drow0 = (n0 >> 7) * 256 + (n0 & 127) + (up ? 128 : 0);
    } else {
        const int e = mat == 770 ? 256 : mat - 512;
        d.W = mat == 770 ? a->in[I_SWD] + (size_t)l * 262144 : a->in[I_EWD] + ((size_t)l * 256 + e) * 262144;
        const int kb = sub >> 5, nb = sub & 31;
        d.N = 1024; d.k0 = 64 * kb; d.n0 = 32 * nb; d.dst = a->ws + WS_ED + (size_t)e * 1024 * 256; d.Kd = 256; d.drow0 = 32 * nb;
    }
    return d;
}
__device__ __forceinline__ void convert_expert_items3(KArgs a, int l, int it0, int it1, int it2, LAS float* scr, int lane) {
    asm volatile("s_waitcnt vmcnt(0) lgkmcnt(0)\n\ts_nop 15\n\ts_nop 15" ::: "memory");
    const ConvItem d0 = expert_item(a, l, it0), d1 = expert_item(a, l, it1), d2 = expert_item(a, l, it2);
    float t0[32], t1[32], t2[32];
    if (d0.valid) conv_load(d0, t0, lane);
    if (d1.valid) conv_load(d1, t1, lane);
    if (d2.valid) conv_load(d2, t2, lane);
    if (d0.valid) conv_store(d0, t0, scr, lane);
    if (d1.valid) conv_store(d1, t1, scr, lane);
    if (d2.valid) conv_store(d2, t2, scr, lane);
}

__device__ __forceinline__ void ln_store(f32x4 (&v)[4], const float* g, const float* b, float* out32, bf16_t* outb, unsigned char* out8, int lane) {
    float s = 0.f;
#pragma unroll
    for (int j = 0; j < 4; ++j) s += (v[j].x + v[j].y) + (v[j].z + v[j].w);
    const float mean = wave_sum(s) * (1.f / 1024.f); float s2 = 0.f;
#pragma unroll
    for (int j = 0; j < 4; ++j) { v[j] = v[j] - mean; s2 += (v[j].x * v[j].x + v[j].y * v[j].y) + (v[j].z * v[j].z + v[j].w * v[j].w); }
    const float rstd = 1.f / sqrtf(wave_sum(s2) * (1.f / 1024.f) + LN_EPS);
#pragma unroll
    for (int j = 0; j < 4; ++j) { const f32x4 gg = *(const f32x4*)(g + 4 * lane + 256 * j), bb = *(const f32x4*)(b + 4 * lane + 256 * j);
        const f32x4 o = v[j] * rstd * gg + bb;
        if (out32) *(f32x4*)(out32 + 4 * lane + 256 * j) = o;
        if (outb) { u32x2 w; w.x = pk2(o.x, o.y); w.y = pk2(o.z, o.w); *(u32x2*)(outb + 4 * lane + 256 * j) = w; }
        if (out8) { int p = 0; p = __builtin_amdgcn_cvt_pk_fp8_f32(o.x, o.y, p, false); p = __builtin_amdgcn_cvt_pk_fp8_f32(o.z, o.w, p, true); *(int*)(out8 + 4 * lane + 256 * j) = p; } }
}

__device__ __forceinline__ f32x4 ldfp8x4(const unsigned char* p) { const int y = *(const int*)p; const f32x2 lo = __builtin_amdgcn_cvt_pk_f32_fp8(y, false), hi = __builtin_amdgcn_cvt_pk_f32_fp8(y, true); return (f32x4){lo.x, lo.y, hi.x, hi.y} * (1.0f / 32.0f); }
__device__ __forceinline__ f32x4 ldbf4(const bf16_t* p) { const u32x2 y = *(const u32x2*)p; return (f32x4){bflo(y.x), bfhi(y.x), bflo(y.y), bfhi(y.y)}; }

constexpr int AT_KP = 144;
constexpr int AT_KP8 = 80;
constexpr int AT_KB = 64 * AT_KP8;
constexpr int AT_VB = 128 * AT_KP8;
constexpr int AT_K0 = 0, AT_V0 = 2 * AT_KB;
constexpr int AT_O1 = 30720;
constexpr int AT_KN = 96256, AT_RED = 96256 + 128;
typedef short v4i16_t __attribute__((ext_vector_type(4)));
__device__ __forceinline__ s16x4 ds_tr(const LAS unsigned char* p) { return __builtin_bit_cast(s16x4, __builtin_amdgcn_ds_read_tr16_b64_v4i16((LAS v4i16_t*)p)); }
__device__ __forceinline__ bf16x8 cat8(s16x4 a, s16x4 b) { return (bf16x8){a[0], a[1], a[2], a[3], b[0], b[1], b[2], b[3]}; }
#define CROWF(r) ((float)(((r) & 3) + 8 * ((r) >> 2)))
__device__ __forceinline__ float xhalf_max(float v) { const auto r = __builtin_amdgcn_permlane32_swap(__float_as_uint(v), __float_as_uint(v), false, false); return fmaxf(__uint_as_float(r[0]), __uint_as_float(r[1])); }
__device__ __forceinline__ float xhalf_sum(float v) { const auto r = __builtin_amdgcn_permlane32_swap(__float_as_uint(v), __float_as_uint(v), false, false); return __uint_as_float(r[0]) + __uint_as_float(r[1]); }

__device__ __forceinline__ int attn_tile(int i, int qb) {
    const int c0 = 4 * qb; if (i < 4) return c0 + i;
    const int nr = 32 - (c0 + 4), nl = c0, j = i - 4;
    const int pairs = nr < nl ? nr : nl;
    if (j < 2 * pairs) return (j & 1) ? c0 - 1 - (j >> 1) : c0 + 4 + (j >> 1);
    const int k = j - 2 * pairs; return nr > nl ? c0 + 4 + pairs + k : c0 - 1 - pairs - k;
}
__device__ __forceinline__ void diffattn_unit(KArgs a, int l, int b, int h, int qb, float lam, LAS unsigned char* lds, const int tid) {
    asm volatile("s_waitcnt vmcnt(0) lgkmcnt(0)\n\ts_nop 15\n\ts_nop 15" ::: "memory");
    const int lane = tid & 63, r32 = lane & 31, hi = lane >> 5; const int wid = __builtin_amdgcn_readfirstlane(tid >> 6);
    const unsigned char* QA = (const unsigned char*)(a->ws + WS_QA); const unsigned char* KA = (const unsigned char*)(a->ws + WS_KA); const unsigned char* VT = (const unsigned char*)(a->ws + WS_VA);
    const size_t tok0 = (size_t)b * SEQ;
    const int qw0 = qb * 256 + wid * 32, qpos = qw0 + r32;
    const float slope2 = exp2f(-(float)(h + 1)) * LOG2E;
    const int krow = tid >> 3, kch = tid & 7;
    const int vrow0 = tid >> 2, vch = tid & 3;
    const unsigned koff = (unsigned)(krow * 1024 + kch * 8), voff = (unsigned)(vrow0 * 2048 + vch * 16);
    const unsigned kdst = (unsigned)(krow * AT_KP8 + kch * 8);
    const unsigned vdst = (unsigned)(vrow0 * AT_KP8 + vch * 16);
    const unsigned kfr = (unsigned)(r32 * AT_KP8 + hi * 32);
    const unsigned vfr = (unsigned)(r32 * AT_KP8 + hi * 32);
    const float fq4 = (float)(qpos - 4 * hi);
    bf16x8 kx0, kx1;
    { const unsigned one2 = 0x3f803f80u, z = 0u; const unsigned k0 = f2bf((float)r32), k1 = f2bf((float)(r32 + 32));
      const u32x4 w0 = hi ? (u32x4){z, z, z, z} : (u32x4){one2, 0x3f80u | (k0 << 16), k0, z}, w1 = hi ? (u32x4){z, z, z, z} : (u32x4){one2, 0x3f80u | (k1 << 16), k1, z};
      kx0 = __builtin_bit_cast(bf16x8, w0); kx1 = __builtin_bit_cast(bf16x8, w1); }
    const unsigned s2h = f2bf(slope2); const unsigned s2l = f2bf(slope2 - bflo(s2h));
    LAS unsigned* o1l = (LAS unsigned*)(lds + AT_O1 + wid * 8192) + lane;
    f32x16 o[4];
    float linv_keep = 0.f;
    if (wid >= 4) __builtin_amdgcn_s_setprio(1);
#pragma unroll 1
    for (int p = 0; p < 2; ++p) {
        const unsigned char* Kp = KA + tok0 * 1024 + h * 128 + p * 64;
        const unsigned char* Vp = VT + (size_t)((b * 8 + h) * 128) * 2048;
        const char* const Kpc = (const char*)Kp; const char* const Vpc = (const char*)Vp;
#define AT_LDK(t_) (*(const u32x2*)(Kpc + (size_t)((unsigned)((t_) << 16) + koff)))
#define AT_LDV0(t_) (*(const u32x4*)(Vpc + (size_t)((unsigned)((t_) << 6) + voff)))
        i32x8 qf;
        { const i32x4 q0 = *(const i32x4*)(QA + (tok0 + qpos) * 1024 + h * 128 + p * 64 + hi * 32), q1 = *(const i32x4*)(QA + (tok0 + qpos) * 1024 + h * 128 + p * 64 + hi * 32 + 16);
          qf = __builtin_shufflevector(q0, q1, 0, 1, 2, 3, 4, 5, 6, 7); }
        float m = 0.f, lsum = 0.f;
        float qn2 = 0.f;
#pragma unroll
        for (int j = 0; j < 8; ++j) { const f32x2 x0 = __builtin_amdgcn_cvt_pk_f32_fp8(qf[j], false), x1 = __builtin_amdgcn_cvt_pk_f32_fp8(qf[j], true); qn2 += (x0.x * x0.x + x0.y * x0.y) + (x1.x * x1.x + x1.y * x1.y); }
        qn2 = xhalf_sum(qn2) * (1.0f / (QA8_SCALE * QA8_SCALE));
#pragma unroll
        for (int o_ = 1; o_ < 32; o_ <<= 1) qn2 = fmaxf(qn2, __shfl_xor(qn2, o_));
        qn2 = __uint_as_float((unsigned)__builtin_amdgcn_readfirstlane((int)__float_as_uint(qn2)));
        if (tid < 32) ((LAS unsigned*)(lds + AT_KN))[tid] = 0u;
        __syncthreads();
        const bool can_skip = slope2 * 1793.0f > 48.0f;
#pragma unroll 1
        for (int j0 = 0; can_skip && j0 < SEQ / 64; j0 += 16) { u32x2 kk[16];
#pragma unroll
            for (int j = 0; j < 16; ++j) kk[j] = AT_LDK(j0 + j);
#pragma unroll
            for (int j = 0; j < 16; ++j) { float ss = 0.f;
#pragma unroll
                for (int c = 0; c < 2; ++c) { const f32x2 x0 = __builtin_amdgcn_cvt_pk_f32_fp8((int)kk[j][c], false), x1 = __builtin_amdgcn_cvt_pk_f32_fp8((int)kk[j][c], true); ss += (x0.x * x0.x + x0.y * x0.y) + (x1.x * x1.x + x1.y * x1.y); }
                ss *= QA8_SCALE * QA8_SCALE;
                ss += __shfl_xor(ss, 1); ss += __shfl_xor(ss, 2); ss += __shfl_xor(ss, 4);
                ss = fmaxf(ss, __shfl_xor(ss, 8)); ss = fmaxf(ss, __shfl_xor(ss, 16)); ss = fmaxf(ss, __shfl_xor(ss, 32));
                if (lane == 0) (void)__hip_atomic_fetch_max((LAS unsigned*)(lds + AT_KN) + j0 + j, __float_as_uint(ss), __ATOMIC_RELAXED, __HIP_MEMORY_SCOPE_WORKGROUP); } }
#pragma unroll
        for (int e = 0; e < 4; ++e) o[e] = (f32x16){};
        unsigned keep = 0xFFFFFFFFu; int n = 0, ic = 0, i1 = 1, i2 = 2;
        int kt = attn_tile(0, qb);
        u32x2 kreg = AT_LDK(kt);
        u32x4 vreg0 = AT_LDV0(kt);
        *(LAS u32x2*)(lds + AT_K0 + kdst) = kreg; *(LAS u32x4*)(lds + AT_V0 + vdst) = vreg0;
        { const int k1 = attn_tile(1, qb);
          kreg = AT_LDK(k1);
          vreg0 = AT_LDV0(k1); }
        __syncthreads();
#pragma unroll 1
        for (; ic < SEQ / 64; ++n) {
            const int it = n;
            const int cb = n & 1;
            if (n == 4 && can_skip) {
                const LAS float* red = (const LAS float*)(lds + AT_RED); float A2 = red[0], Mm = red[1];
#pragma unroll
                for (int w = 1; w < 8; ++w) { A2 = fmaxf(A2, red[2 * w]); Mm = fminf(Mm, red[2 * w + 1]); }
                const int i = lane & 31, t = attn_tile(i, qb);
                const int dmin = t * 64 > qb * 256 + 255 ? t * 64 - (qb * 256 + 255) : qb * 256 - (t * 64 + 63);
                const float kn2 = __uint_as_float(((const LAS unsigned*)(lds + AT_KN))[t]);
                const float bound = sqrtf(A2 * kn2) * 1.0001f - Mm - slope2 * (float)dmin;
                const bool kp = !(bound < -36.0f);
                keep = (unsigned)__builtin_amdgcn_readfirstlane((int)(unsigned)(__ballot(kp) & 0xFFFFFFFFull)) | 0x3Fu;
                i1 = 5; { const unsigned r = keep & ~0x3Fu; i2 = r ? __builtin_ctz(r) : 32; }
            }
            const int ktn = (i1 < SEQ / 64) ? attn_tile(i1, qb) : kt;
            if (i1 < SEQ / 64) {
                const int nb = cb ^ 1;
                *(LAS u32x2*)(lds + AT_K0 + nb * AT_KB + kdst) = kreg; *(LAS u32x4*)(lds + AT_V0 + nb * AT_VB + vdst) = vreg0;
                if (i2 < SEQ / 64) { const int k2 = attn_tile(i2, qb);
                    kreg = AT_LDK(k2);
                    vreg0 = AT_LDV0(k2); }
            }
            const LAS unsigned char* Kb = lds + AT_K0 + cb * AT_KB; const LAS unsigned char* Vb = lds + AT_V0 + cb * AT_VB;
            const int cls = (kt * 64 + 63 < qw0) ? 0 : ((kt * 64 > qw0 + 31) ? 1 : 2);
            f32x16 p0, p1;
            i32x8 ka, kb2;
            ka = __builtin_shufflevector(*(const LAS i32x4*)(Kb + kfr), *(const LAS i32x4*)(Kb + kfr + 16), 0, 1, 2, 3, 4, 5, 6, 7);
            kb2 = __builtin_shufflevector(*(const LAS i32x4*)(Kb + kfr + 32 * AT_KP8), *(const LAS i32x4*)(Kb + kfr + 32 * AT_KP8 + 16), 0, 1, 2, 3, 4, 5, 6, 7);
            { const float ts = cls == 0 ? slope2 * ((float)(kt * 64) - fq4 - 4.f * (float)hi) : (cls == 1 ? slope2 * (fq4 + 4.f * (float)hi - (float)(kt * 64)) : 0.f);
              const float S = ts - m; const unsigned sa = f2bf(S); const float r1 = S - bflo(sa); const unsigned sb = f2bf(r1); const unsigned sc = f2bf(r1 - bflo(sb));
              const unsigned sg_ = cls == 1 ? 0x8000u : 0u; const unsigned sh = cls == 2 ? 0u : (s2h ^ sg_), sl = cls == 2 ? 0u : (s2l ^ sg_);
              const u32x4 qw = (u32x4){sa | (sb << 16), sc | (sh << 16), sl, 0u};
              const bf16x8 qx = __builtin_bit_cast(bf16x8, qw);
              asm volatile("v_mfma_f32_32x32x64_f8f6f4 %0, %1, %2, 0" : "=&v"(p0) : "v"(ka), "v"(qf));
              asm volatile("v_mfma_f32_32x32x64_f8f6f4 %0, %1, %2, 0" : "=&v"(p1) : "v"(kb2), "v"(qf));
              asm volatile("s_nop 15\n\ts_nop 7" : "+v"(p0), "+v"(p1));
              p0 = __builtin_amdgcn_mfma_f32_32x32x16_bf16(kx0, qx, p0, 0, 0, 0); p1 = __builtin_amdgcn_mfma_f32_32x32x16_bf16(kx1, qx, p1, 0, 0, 0); }
            i32x8 vt[4];
#pragma unroll
            for (int e = 0; e < 4; ++e) vt[e] = __builtin_shufflevector(*(const LAS i32x4*)(Vb + vfr + e * 32 * AT_KP8), *(const LAS i32x4*)(Vb + vfr + e * 32 * AT_KP8 + 16), 0, 1, 2, 3, 4, 5, 6, 7);
            __builtin_amdgcn_sched_barrier(0);
            if (cls == 2) {
                const float fqh = fq4 - (float)(kt * 64);
#pragma unroll
                for (int r = 0; r < 16; ++r) { p0[r] = p0[r] - slope2 * fabsf(fqh - CROWF(r)); p1[r] = p1[r] - slope2 * fabsf(fqh - 32.f - CROWF(r)); }
            }
            float mx = fmaxf(fmaxf(p0[0], p0[1]), fmaxf(p1[0], p1[1]));
#pragma unroll
            for (int r = 2; r < 16; r += 2) { mx = fmaxf(fmaxf(mx, p0[r]), p0[r + 1]); mx = fmaxf(fmaxf(mx, p1[r]), p1[r + 1]); }
            mx = xhalf_max(mx);
            if (it == 0 || !__all(mx <= 8.0f)) {
                const float dl = it == 0 ? mx - 4.0f : fmaxf(mx - 4.0f, 0.f), alpha = it == 0 ? 1.0f : __builtin_amdgcn_exp2f(-dl); m += dl; lsum *= alpha;
                asm volatile("s_nop 15\n\ts_nop 7" ::: "memory");
#pragma unroll
                for (int e = 0; e < 4; ++e)
#pragma unroll
                    for (int r = 0; r < 16; ++r) o[e][r] *= alpha;
#pragma unroll
                for (int r = 0; r < 16; ++r) { p0[r] -= dl; p1[r] -= dl; }
            }
            float rs = 0.f;
#pragma unroll
            for (int r = 0; r < 16; ++r) { p0[r] = __builtin_amdgcn_exp2f(p0[r]); p1[r] = __builtin_amdgcn_exp2f(p1[r]); rs += p0[r] + p1[r]; }
            lsum += rs;
            i32x8 pb;
#pragma unroll
            for (int i = 0; i < 4; ++i) { int w0 = 0, w1 = 0;
                w0 = __builtin_amdgcn_cvt_pk_fp8_f32(p0[4 * i + 0], p0[4 * i + 1], w0, false); w0 = __builtin_amdgcn_cvt_pk_fp8_f32(p0[4 * i + 2], p0[4 * i + 3], w0, true);
                w1 = __builtin_amdgcn_cvt_pk_fp8_f32(p1[4 * i + 0], p1[4 * i + 1], w1, false); w1 = __builtin_amdgcn_cvt_pk_fp8_f32(p1[4 * i + 2], p1[4 * i + 3], w1, true);
                pb[i] = w0; pb[4 + i] = w1; }
            asm volatile("s_nop 3" : "+v"(pb));
#pragma unroll
            for (int e = 0; e < 4; ++e) asm volatile("v_mfma_f32_32x32x64_f8f6f4 %0, %1, %2, %0" : "+v"(o[e]) : "v"(vt[e]), "v"(pb));
            if (n == 3) {
                float mm = m;
#pragma unroll
                for (int o_ = 1; o_ < 32; o_ <<= 1) mm = fminf(mm, __shfl_xor(mm, o_));
                if (lane == 0) { LAS float* red = (LAS float*)(lds + AT_RED); red[2 * wid] = qn2; red[2 * wid + 1] = mm; }
            }
            kt = ktn; ic = i1; i1 = i2;
            { const unsigned r = (i2 < 31) ? (keep & (0xFFFFFFFEu << i2)) : 0u; i2 = r ? __builtin_ctz(r) : 32; }
            __syncthreads();
        }
        asm volatile("s_nop 15\n\ts_nop 7" ::: "memory");
        const float linv = (1.0f / V8_SCALE) / xhalf_sum(lsum);
        if (p == 0) {
#pragma unroll
            for (int e = 0; e < 4; ++e)
#pragma unroll
                for (int r = 0; r < 16; r += 2) o1l[(e * 8 + (r >> 1)) * 64] = cvt_pk_bf16(o[e][r] * linv, o[e][r + 1] * linv);
        } else linv_keep = linv;
    }
#undef AT_LDK
#undef AT_LDV0
#undef AT_LDV1
    __builtin_amdgcn_s_setprio(0);
    float ss = 0.f;
#pragma unroll
    for (int e = 0; e < 4; ++e)
#pragma unroll
        for (int r = 0; r < 16; r += 2) { const unsigned w = o1l[(e * 8 + (r >> 1)) * 64];
            o[e][r] = bflo(w) - lam * (o[e][r] * linv_keep); o[e][r + 1] = bfhi(w) - lam * (o[e][r + 1] * linv_keep);
            ss += o[e][r] * o[e][r] + o[e][r + 1] * o[e][r + 1]; }
    ss = xhalf_sum(ss);
    const float lam_init = 0.8f - 0.6f * expf(-0.3f * (float)l);
    const float rn = (1.0f / sqrtf(ss * (1.f / 128.f) + LN_EPS)) * (1.0f - lam_init);
    const float* sg = a->in[I_SUBG] + l * 128;
    unsigned char* orow = (unsigned char*)(a->ws + WS_OA8) + (tok0 + qpos) * 1024 + h * 128;
    const float rn8 = rn * OA8_SCALE;
#pragma unroll
    for (int e = 0; e < 4; ++e)
#pragma unroll
        for (int r4 = 0; r4 < 4; ++r4) { const int ecol = 32 * e + 8 * r4 + 4 * hi; const f32x4 g = *(const f32x4*)(sg + ecol);
            int pk = 0; pk = __builtin_amdgcn_cvt_pk_fp8_f32(o[e][4 * r4 + 0] * rn8 * g.x, o[e][4 * r4 + 1] * rn8 * g.y, pk, false); pk = __builtin_amdgcn_cvt_pk_fp8_f32(o[e][4 * r4 + 2] * rn8 * g.z, o[e][4 * r4 + 3] * rn8 * g.w, pk, true);
            *(int*)(orow + ecol) = pk; }
}

constexpr int NA_NINF_OFF = TAB_OFF + 3072;
constexpr int NA_RPB_OFF = 101312, NA_V_OFF = 0, NA_SCR_OFF = 32768;
__device__ __forceinline__ void na_wave_unit(KArgs a, int uidx, LAS unsigned char* lds, int wave, int lane) {
    asm volatile("s_waitcnt vmcnt(0) lgkmcnt(0)\n\ts_nop 15\n\ts_nop 15" ::: "memory");
    const int r32 = lane & 31, hi = lane >> 5;
    const int qbh = uidx & 1, head = (uidx >> 1) & 15, r = (uidx >> 5) & 31, b = uidx >> 10;
    const bf16_t* QN = (const bf16_t*)(a->ws + WS_QN); const bf16_t* KN = (const bf16_t*)(a->ws + WS_KN); const bf16_t* VN = (const bf16_t*)(a->ws + WS_VN);
    LAS unsigned char* Vw = lds + NA_V_OFF + wave * 4096;
    LAS unsigned char* Kw = lds + NA_SCR_OFF + wave * 8448;
    const int c = 32 * qbh + r32; const size_t tq = (size_t)b * SEQ + r * 64 + c;
    const int rs = min(max(r - 4, 0), 24), cs = min(max(c - 8, 0), 48);
    bf16x8 qf[2];
#pragma unroll
    for (int d0 = 0; d0 < 2; ++d0) qf[d0] = *(const bf16x8*)(QN + tq * 512 + head * 32 + d0 * 16 + hi * 8);
    const unsigned vfr = (unsigned)(((lane >> 4) & 1) * 32 + (lane & 3) * 8 + (4 * hi + ((lane & 15) >> 2)) * 64);
    float m = -1e30f, lsum = 0.f; f32x16 o = (f32x16){};
    const int fb = 32 * qbh, hb = qbh ? 24 : 32;
    unsigned ad0[16], ad1[4];
    { const unsigned base = (unsigned)(NA_RPB_OFF + (head * 465 + (rs - r + 7) * 31 + (15 - c)) * 4);
#pragma unroll
      for (int rr = 0; rr < 16; ++rr) { const int kc0 = fb + (rr & 3) + 8 * (rr >> 2) + 4 * hi;
          const bool v0 = (kc0 >= cs) && (kc0 < cs + 16);
          ad0[rr] = v0 ? base + (unsigned)(kc0 * 4) : (unsigned)NA_NINF_OFF; }
#pragma unroll
      for (int rr = 0; rr < 4; ++rr) { const int kc1 = hb + rr + 4 * hi;
          const bool v1 = (kc1 >= cs) && (kc1 < cs + 16);
          ad1[rr] = v1 ? base + (unsigned)(kc1 * 4) : (unsigned)NA_NINF_OFF; } }
    u32x4 kr4[3]; u32x4 vr[3];
    const unsigned char* KNh = (const unsigned char*)KN + ((size_t)(b * 16 + head) * 2048 + 16 * qbh) * 64 + lane * 16;
    const unsigned char* VNh = (const unsigned char*)VN + ((size_t)(b * 16 + head) * 2048 + 16 * qbh) * 64 + lane * 16;
    const int kst = 16 * qbh + (lane >> 2);
#pragma unroll
    for (int j = 0; j < 3; ++j) kr4[j] = *(const u32x4*)(KNh + (size_t)(rs * 4096 + j * 1024));
#pragma unroll
    for (int j = 0; j < 3; ++j) vr[j] = *(const u32x4*)(VNh + (size_t)(rs * 4096 + j * 1024));
#pragma unroll 1
    for (int kr = 0; kr < 8; ++kr) {
        const int R = rs + kr;
#pragma unroll
        for (int j = 0; j < 3; ++j) *(LAS u32x4*)(Vw + (kst + 16 * j) * 64 + (lane & 3) * 16) = vr[j];
#pragma unroll
        for (int j = 0; j < 3; ++j) *(LAS u32x4*)(Kw + (kst + 16 * j) * 80 + (lane & 3) * 16) = kr4[j];
        if (kr + 1 < 8) {
#pragma unroll
            for (int j = 0; j < 3; ++j) { kr4[j] = *(const u32x4*)(KNh + (size_t)((R + 1) * 4096 + j * 1024));
                vr[j] = *(const u32x4*)(VNh + (size_t)((R + 1) * 4096 + j * 1024)); }
        }
        bf16x8 kc[4];
#pragma unroll
        for (int d0 = 0; d0 < 2; ++d0) { kc[2 * d0] = *(const LAS bf16x8*)(Kw + (fb + r32) * 80 + d0 * 32 + hi * 16); kc[2 * d0 + 1] = *(const LAS bf16x8*)(Kw + (hb + r32) * 80 + d0 * 32 + hi * 16); }
        f32x16 p0, p1 = (f32x16){};
#pragma unroll
        for (int rr = 0; rr < 16; ++rr) { p0[rr] = *(const LAS float*)(lds + ad0[rr]); ad0[rr] += 124u; }
#pragma unroll
        for (int rr = 0; rr < 4; ++rr) { p1[rr] = *(const LAS float*)(lds + ad1[rr]); ad1[rr] += 124u; }
        asm volatile("s_waitcnt lgkmcnt(0)" ::: "memory");
#pragma unroll
        for (int d0 = 0; d0 < 2; ++d0) {
            p0 = __builtin_amdgcn_mfma_f32_32x32x16_bf16(kc[2 * d0], qf[d0], p0, 0, 0, 0);
            p1 = __builtin_amdgcn_mfma_f32_32x32x16_bf16(kc[2 * d0 + 1], qf[d0], p1, 0, 0, 0);
        }
        float mx = fmaxf(p0[0], p1[0]);
#pragma unroll
        for (int rr = 1; rr < 16; ++rr) mx = rr < 4 ? fmaxf(fmaxf(mx, p0[rr]), p1[rr]) : fmaxf(mx, p0[rr]);
        mx = xhalf_max(mx);
        const float mn = fmaxf(fmaxf(m, mx), -1e30f), alpha = __builtin_amdgcn_exp2f(m - mn); m = mn;
        float rsum = 0.f;
#pragma unroll
        for (int rr = 0; rr < 16; ++rr) { p0[rr] = __builtin_amdgcn_exp2f(p0[rr] - mn); rsum += p0[rr]; }
#pragma unroll
        for (int rr = 0; rr < 4; ++rr) { p1[rr] = __builtin_amdgcn_exp2f(p1[rr] - mn); rsum += p1[rr]; }
        lsum = lsum * alpha + rsum;
#pragma unroll
        for (int rr = 0; rr < 16; ++rr) o[rr] *= alpha;
        bf16x8 pb[3];
#pragma unroll
        for (int s = 0; s < 2; ++s) { u32x4 w; w.x = cvt_pk_bf16(p0[8 * s + 0], p0[8 * s + 1]); w.y = cvt_pk_bf16(p0[8 * s + 2], p0[8 * s + 3]); w.z = cvt_pk_bf16(p0[8 * s + 4], p0[8 * s + 5]); w.w = cvt_pk_bf16(p0[8 * s + 6], p0[8 * s + 7]);
            pb[s] = __builtin_bit_cast(bf16x8, w); }
        { u32x4 w; w.x = cvt_pk_bf16(p1[0], p1[1]); w.y = cvt_pk_bf16(p1[2], p1[3]); w.z = 0u; w.w = 0u; pb[2] = __builtin_bit_cast(bf16x8, w); }
        s16x4 lo[3], hi4[3];
#pragma unroll
        for (int s = 0; s < 2; ++s) { lo[s] = ds_tr(Vw + vfr + (fb + 16 * s) * 64); hi4[s] = ds_tr(Vw + vfr + (fb + 16 * s) * 64 + 512); }
        lo[2] = ds_tr(Vw + vfr + hb * 64); hi4[2] = ds_tr(Vw + vfr + hb * 64 + 512);
        asm volatile("s_waitcnt lgkmcnt(0)" ::: "memory");
#pragma unroll
        for (int s = 0; s < 3; ++s) o = __builtin_amdgcn_mfma_f32_32x32x16_bf16(cat8(lo[s], hi4[s]), pb[s], o, 0, 0, 0);
    }
    const float linv = OB8_SCALE / xhalf_sum(lsum);
    unsigned char* orow = (unsigned char*)(a->ws + WS_OB8) + (size_t)tq * 512 + head * 32;
#pragma unroll
    for (int r4 = 0; r4 < 4; ++r4) { const int ecol = 8 * r4 + 4 * hi;
        int pk = 0; pk = __builtin_amdgcn_cvt_pk_fp8_f32(o[4 * r4 + 0] * linv, o[4 * r4 + 1] * linv, pk, false); pk = __builtin_amdgcn_cvt_pk_fp8_f32(o[4 * r4 + 2] * linv, o[4 * r4 + 3] * linv, pk, true);
        *(int*)(orow + ecol) = pk; }
}

__device__ __forceinline__ void build_table(const unsigned* cnt, LAS unsigned char* lds) {
    LAS int* tab = (LAS int*)(lds + TAB_OFF); LAS int* tmp = (LAS int*)(lds + TAB_OFF + 2048);
    int tid_ = threadIdx.x; asm volatile("" : "+v"(tid_));
    const int tid = tid_;
    __syncthreads();
    if (tid < 256) tmp[tid] = (int)((__hip_atomic_load(cnt + tid, __ATOMIC_RELAXED, __HIP_MEMORY_SCOPE_AGENT) + 255u) >> 8);
    __syncthreads();
    if (tid < 256) { int s = 0; for (int j = 0; j < tid; ++j) s += tmp[j]; tab[tid] = s; if (tid == 255) { tab[256] = s + tmp[255]; tab[257] = s + tmp[255] + T / 256; } }
    __syncthreads();
}

__device__ __forceinline__ float route_sig(float x) { return 1.0f / (1.0f + expf(-x)); }
__device__ __forceinline__ void route_phase(KArgs a, int l, LAS unsigned char* lds, int G) {
    int tid_ = threadIdx.x; asm volatile("" : "+v"(tid_));
    const int tid = tid_;
    const float* LT = (const float*)(a->ws + WS_LOGIT); const float* rbias = a->in[I_RB] + l * 256;
    int* reidx = (int*)(a->ws + WS_REIDX); int* rpos = (int*)(a->ws + WS_RPOS); float* rw = (float*)(a->ws + WS_RW);
    unsigned* cnt = (unsigned*)(a->ws + WS_CTL) + CW_CNT + l * 256;
    LAS int* hist = (LAS int*)lds; LAS int* base = hist + 256; LAS int* le = base + 256; LAS int* lp = le + 2048; LAS float* lb = (LAS float*)(lp + 2048); LAS float* gsl = lb + 256;
    for (int panel = blockIdx.x; panel < T / 256; panel += G) {
        __syncthreads();
        if (tid < 256) { hist[tid] = 0; lb[tid] = rbias[tid]; }
        __syncthreads();
        { const int tok = tid & 255, half = __builtin_amdgcn_readfirstlane(tid >> 8); const float* lt = LT + (size_t)panel * 256 + tok;
#pragma unroll
          for (int g4 = 0; g4 < 4; ++g4) { const int g = 4 * half + g4; float m1 = -INFINITY, m2 = -INFINITY;
              float x[32];
#pragma unroll
              for (int j = 0; j < 32; ++j) x[j] = lt[(size_t)(g * 32 + j) * T];
#pragma unroll
              for (int j = 0; j < 32; ++j) { const float v = route_sig(x[j]) + lb[g * 32 + j]; const float t = fminf(m1, v); m1 = fmaxf(m1, v); m2 = fmaxf(m2, t); }
              gsl[tok * 9 + g] = m1 + m2; } }
        __syncthreads();
        if (tid < 256) {
            const size_t row = (size_t)panel * 256 + tid; const float* lt = LT + row;
            float gs[8];
#pragma unroll
            for (int g = 0; g < 8; ++g) gs[g] = gsl[tid * 9 + g];
            unsigned gmask = 0;
#pragma unroll
            for (int g = 0; g < 8; ++g) { int rank = 0;
#pragma unroll
                for (int j = 0; j < 8; ++j) rank += (gs[j] > gs[g] || (gs[j] == gs[g] && j < g)) ? 1 : 0;
                if (rank < 4) gmask |= 1u << g; }
            float tv[8]; int te[8];
#pragma unroll
            for (int k = 0; k < 8; ++k) { tv[k] = -INFINITY; te[k] = 0; }
#pragma unroll 1
            for (int g = 0; g < 8; ++g) { if (!((gmask >> g) & 1u)) continue;
                float x[32];
#pragma unroll
                for (int j = 0; j < 32; ++j) x[j] = lt[(size_t)(g * 32 + j) * T];
#pragma unroll
                for (int j = 0; j < 32; ++j) { const int e = g * 32 + j; float v = route_sig(x[j]) + lb[e];
                    if (v > tv[7]) { int ev = e; bool ins = false;
#pragma unroll
                        for (int k = 0; k < 8; ++k) { ins = ins || (v > tv[k]); const bool sw = ins;   const float tvv = tv[k]; const int tee = te[k]; tv[k] = sw ? v : tvv; te[k] = sw ? ev : tee; v = sw ? tvv : v; ev = sw ? tee : ev; } } } }
            float gv[8], gsum = 0.f;
#pragma unroll
            for (int k = 0; k < 8; ++k) { gv[k] = tv[k] - lb[te[k]]; gsum += gv[k]; }
            const float sc = ROUTE_SCALE / gsum;
#pragma unroll
            for (int k = 0; k < 8; ++k) { const int pos = atomicAdd((int*)&hist[te[k]], 1); le[tid * 8 + k] = te[k]; lp[tid * 8 + k] = pos; rw[row * 8 + k] = gv[k] * sc; }
        }
        __syncthreads();
        if (tid < 256) { const int c = hist[tid]; base[tid] = c ? (int)__hip_atomic_fetch_add(cnt + tid, (unsigned)c, __ATOMIC_RELAXED, __HIP_MEMORY_SCOPE_AGENT) : 0; }
        __syncthreads();
        for (int i = tid; i < 2048; i += 512) { const int e = le[i]; const size_t gi = (size_t)panel * 2048 + i; reidx[gi] = e; rpos[gi] = base[e] + lp[i]; }
    }
}

__device__ __forceinline__ void slot_phase(KArgs a, int l, LAS unsigned char* lds, int G) {
    int tid_ = threadIdx.x; asm volatile("" : "+v"(tid_));
    const int tid = tid_;
    const LAS int* tab = (const LAS int*)(lds + TAB_OFF);
    const int* reidx = (const int*)(a->ws + WS_REIDX); const int* rpos = (const int*)(a->ws + WS_RPOS); const float* rw = (const float*)(a->ws + WS_RW);
    int* stok = (int*)(a->ws + WS_STOK); u32x2* sinf = (u32x2*)(a->ws + WS_SDST);
    const unsigned* cnt = (const unsigned*)(a->ws + WS_CTL) + CW_CNT + l * 256;
    for (size_t i = (size_t)blockIdx.x * 512 + tid; i < (size_t)T * 8; i += (size_t)G * 512) {
        const int e = reidx[i]; const int slot = tab[e] * 256 + rpos[i];
        stok[slot] = (int)(i >> 3); sinf[slot] = (u32x2){(unsigned)i, __builtin_bit_cast(unsigned, rw[i])};
    }
    for (int e = blockIdx.x; e < 256; e += G) {
        const int c = (int)__hip_atomic_load(cnt + e, __ATOMIC_RELAXED, __HIP_MEMORY_SCOPE_AGENT); const int pend = ((c + 255) >> 8) << 8;
        for (int s = c + tid; s < pend; s += 512) { const int slot = tab[e] * 256 + s; stok[slot] = 0; sinf[slot] = (u32x2){0xffffffffu, 0u}; }
    }
}

constexpr int NPHASE = 1 + 11 * DEPTH;
#ifndef LBW
#define LBW 2
#endif
#ifndef PHMASK
#define PHMASK 0xFFF
#endif
#define EN(j) (((PHMASK) >> (j)) & 1)
__global__ void __launch_bounds__(NWAVES * 64, LBW) mega_fwd(Args a_kernarg) {
    extern __shared__ __attribute__((aligned(16))) unsigned char lds_raw[];
    LAS unsigned char* lds = (LAS unsigned char*)lds_raw;
    const int G = gridDim.x;
#define PH_IDS KArgs a = kargs(); int tid_ = threadIdx.x; asm volatile("" : "+v"(tid_)); const int tid = tid_, lane = tid & 63; const int wave = __builtin_amdgcn_readfirstlane(tid >> 6); \
    const int gw = blockIdx.x * NWAVES + wave, ngw = G * NWAVES; (void)lane; (void)gw; (void)ngw; (void)a;
    for (int u = threadIdx.x; u < 256; u += NWAVES * 64) ((LAS unsigned*)(lds + MISC_OFF))[u] = 0u;
    __syncthreads();
    int lo, hi;
    { KArgs a0 = kargs(); lo = a0->ph_lo; hi = a0->ph_hi; }
#if MK_ONE_LAUNCH
    XcdBarrier bar;
    { KArgs a0 = kargs(); bar = xcd_barrier_post((unsigned*)(a0->ws + WS_CTL) + CW_BAR, (volatile LAS unsigned*)(lds + MISC_OFF)); }
#define GRID_BAR() xcd_barrier(bar)
#else
#define GRID_BAR() do {} while (0)
#endif
#define IN(k) (lo <= (k) && (k) < hi)
#define SEAM(k) do { if (IN(k) && IN((k) + 1)) GRID_BAR(); } while (0)

    if (EN(11) && IN(0)) {
        PH_IDS
        float* H = a->out; bf16_t* HB = (bf16_t*)(a->ws + WS_HB);
        convert_small(a, lds, gw, ngw, lane, wave);
        for (int m = gw; m < T; m += 2 * ngw) { f32x4 v[4], w[4]; const int m2 = m + ngw; const bool two = m2 < T;
#pragma unroll
            for (int j = 0; j < 4; ++j) v[j] = *(const f32x4*)(a->in[I_X] + (size_t)m * 1024 + 4 * lane + 256 * j);
            if (two) {
#pragma unroll
                for (int j = 0; j < 4; ++j) w[j] = *(const f32x4*)(a->in[I_X] + (size_t)m2 * 1024 + 4 * lane + 256 * j); }
            ln_store(v, a->in[I_EG], a->in[I_EB], nullptr, HB + (size_t)m * 1024, (unsigned char*)(a->ws + WS_HB8) + (size_t)m * 1024, lane);
            if (two) ln_store(w, a->in[I_EG], a->in[I_EB], nullptr, HB + (size_t)m2 * 1024, (unsigned char*)(a->ws + WS_HB8) + (size_t)m2 * 1024, lane); }
    }
    SEAM(0);
#pragma unroll 1
    for (int l = 0; l < DEPTH; ++l) {
        const int pb = 1 + 11 * l;
        if (EN(0) && IN(pb + 0)) {
            KArgs a = kargs();
            { InProjOrder S; S.init((const bf16_t*)(a->ws + WS_HB8), (const bf16_t*)(a->ws + WS_WIN + (size_t)l * NCOL * 1024), T, NCOL - 1024, 512, G, (int)blockIdx.x);
              EpiInProj E{a->ws, a->in[I_BG] + l * 2048};
              pg8::gemm_phase<EpiInProj, InProjOrder, true>(lds, lds + XOFF_LDS, 512, S, E); }
            { KArgs a2 = kargs();
              pg8::DenseOrder S; S.init((const bf16_t*)(a2->ws + WS_WIN + ((size_t)l * NCOL + 2048) * 1024), (const bf16_t*)(a2->ws + WS_HB8), 1024, T, 512, G, (int)blockIdx.x);
              EpiVT E{(unsigned char*)(a2->ws + WS_VA)};
              pg8::gemm_phase<EpiVT, pg8::DenseOrder, true>(lds, lds + XOFF_LDS, 512, S, E); }
        }
        SEAM(pb + 0);
        if (EN(1) && IN(pb + 1)) {
            PH_IDS
            float lam;
            { const float q1 = a->in[I_LQ1][l * 64 + lane] * a->in[I_LK1][l * 64 + lane], q2 = a->in[I_LQ2][l * 64 + lane] * a->in[I_LK2][l * 64 + lane];
              lam = expf(wave_sum(q1)) - expf(wave_sum(q2)) + (0.8f - 0.6f * expf(-0.3f * (float)l));
              lam = __uint_as_float((unsigned)__builtin_amdgcn_readfirstlane((int)__float_as_uint(lam))); }
            { const float* rp = a->in[I_RPB] + (size_t)l * 16 * 465; LAS float* rl = (LAS float*)(lds + NA_RPB_OFF);
              for (int i = tid; i < 16 * 465; i += NWAVES * 64) rl[i] = rp[i] * LOG2E;
              if (tid < 256) ((LAS float*)(lds + NA_NINF_OFF))[tid] = -INFINITY; }
            LAS float* scr = (LAS float*)(lds + NA_SCR_OFF + wave * 8448);
            int k = 0;
            constexpr int NA_UNITS = BATCH * 32 * 16 * 2;
            for (int i = 0;; ++i) { const int L = i * G + (int)blockIdx.x; const bool hasu = L < BATCH * 8 * 8;
                if (hasu) { const int c = L & 255;
                    diffattn_unit(a, l, (c & 7) + 8 * (c >> 6), L >> 8, (c >> 3) & 7, lam, lds, tid);
                    __syncthreads(); }
                for (int j = 0; hasu ? j < 2 : true; ++j) {
                    const int u = gw + k * ngw, it = gw + 3 * k * ngw; if (u >= NA_UNITS && it >= N_EXP_ITEMS) break;
                    ++k;
                    KArgs a2 = kargs(); int lane2 = lane; asm volatile("" : "+v"(lane2));
                    if (u < NA_UNITS) na_wave_unit(a2, u, lds, wave, lane2);
                    convert_expert_items3(a2, l, it, it + ngw, it + 2 * ngw, scr, lane2); }
                if (!hasu) break;
                __syncthreads();
            }
        }
        SEAM(pb + 1);
        if (EN(2) && IN(pb + 2)) {
            { KArgs a = kargs();
              pg8::DenseOrder S; S.init((const bf16_t*)(a->ws + WS_OA8), (const bf16_t*)(a->ws + WS_WPA + (size_t)l * 1024 * 1024), T, 1024, 512, G, (int)blockIdx.x);
              EpiProj<false> E{(bf16_t*)(a->ws + WS_U), (const unsigned char*)(a->ws + WS_GA), nullptr, W8_INV / (OA8_SCALE * G8_SCALE)};
              pg8::gemm_phase<EpiProj<false>, pg8::DenseOrder, true>(lds, lds + XOFF_LDS, 512, S, E); }
            { KArgs a = kargs();
              pg8::DenseOrder S; S.init((const bf16_t*)(a->ws + WS_OB8), (const bf16_t*)(a->ws + WS_WPB + (size_t)l * 1024 * 512), T, 1024, 256, G, (int)blockIdx.x);
              EpiProj<true> E{(bf16_t*)(a->ws + WS_U), (const unsigned char*)(a->ws + WS_GB), (unsigned char*)(a->ws + WS_U8), W8_INV / (OB8_SCALE * G8_SCALE)};
              pg8::gemm_phase<EpiProj<true>, pg8::DenseOrder, true>(lds, lds + XOFF_LDS, 256, S, E); }
        }
        SEAM(pb + 2);
        if (EN(3) && IN(pb + 3)) {
            KArgs a = kargs();
            pg8::DenseOrder S; S.init((const bf16_t*)(a->ws + WS_U8), (const bf16_t*)(a->ws + WS_WOUT + (size_t)l * 1024 * 1024), T, 1024, 512, G, (int)blockIdx.x);
            EpiFp8Plain E{(unsigned char*)(a->ws + WS_MIX), Y_SCALE * W8_INV / U8_SCALE};
            pg8::gemm_phase<EpiFp8Plain, pg8::DenseOrder, true>(lds, lds + XOFF_LDS, 512, S, E);
        }
        SEAM(pb + 3);
        if (EN(4) && IN(pb + 4)) {
            PH_IDS
            float* H = a->out; bf16_t* HB = (bf16_t*)(a->ws + WS_HB);
            for (int m = gw; m < T; m += 2 * ngw) { f32x4 v[4], w[4]; const int m2 = m + ngw < T ? m + ngw : m;
#pragma unroll
                for (int j = 0; j < 4; ++j) v[j] = ldbf4(HB + (size_t)m * 1024 + 4 * lane + 256 * j) * ALPHA + ldfp8x4((const unsigned char*)(a->ws + WS_MIX) + (size_t)m * 1024 + 4 * lane + 256 * j);
#pragma unroll
                for (int j = 0; j < 4; ++j) w[j] = ldbf4(HB + (size_t)m2 * 1024 + 4 * lane + 256 * j) * ALPHA + ldfp8x4((const unsigned char*)(a->ws + WS_MIX) + (size_t)m2 * 1024 + 4 * lane + 256 * j);
                ln_store(v, a->in[I_L1G] + l * 1024, a->in[I_L1B] + l * 1024, nullptr, HB + (size_t)m * 1024, (unsigned char*)(a->ws + WS_HB8) + (size_t)m * 1024, lane);
                ln_store(w, a->in[I_L1G] + l * 1024, a->in[I_L1B] + l * 1024, nullptr, HB + (size_t)m2 * 1024, (unsigned char*)(a->ws + WS_HB8) + (size_t)m2 * 1024, lane); }
        }
        SEAM(pb + 4);
        if (EN(5) && IN(pb + 5)) {
            KArgs a = kargs();
            pg8::DenseOrder S; S.init((const bf16_t*)(a->ws + WS_HB), (const bf16_t*)(a->ws + WS_WR) + (size_t)l * 256 * 1024, T, 256, 1024, G, (int)blockIdx.x);
            EpiF32T E{(float*)(a->ws + WS_LOGIT), T};
            pg8::gemm_phase(lds, lds + XOFF_LDS, 1024, S, E);
        }
        SEAM(pb + 5);
        if (EN(6) && IN(pb + 6)) { KArgs a = kargs(); route_phase(a, l, lds, G); }
        SEAM(pb + 6);
        if (EN(7) && IN(pb + 7)) { KArgs a = kargs(); build_table((unsigned*)(a->ws + WS_CTL) + CW_CNT + l * 256, lds); slot_phase(a, l, lds, G); }
        SEAM(pb + 7);
        if (EN(8) && IN(pb + 8)) {
            KArgs a = kargs();
            build_table((unsigned*)(a->ws + WS_CTL) + CW_CNT + l * 256, lds);
            const LAS int* tab = (const LAS int*)(lds + TAB_OFF);
            ExpertOrderGU S{tab, (const bf16_t*)(a->ws + WS_HB8), (const bf16_t*)(a->ws + WS_EGU), (const int*)(a->ws + WS_STOK), G, (int)blockIdx.x, tab[257] * 2};
            EpiSwiglu E{(unsigned char*)(a->ws + WS_HMID)};
            pg8::gemm_phase<EpiSwiglu, ExpertOrderGU, true>(lds, lds + XOFF_LDS, 512, S, E);
        }
        SEAM(pb + 8);
        if (EN(9) && IN(pb + 9)) {
#ifndef NO9A
            { KArgs a = kargs();
              build_table((unsigned*)(a->ws + WS_CTL) + CW_CNT + l * 256, lds);
              const LAS int* tab = (const LAS int*)(lds + TAB_OFF);
              ExpertOrderDown S{tab, (const bf16_t*)(a->ws + WS_HMID), (const bf16_t*)(a->ws + WS_ED), G, (int)blockIdx.x, tab[256] * 4};
              EpiDown E{(unsigned char*)(a->ws + WS_Y), (const u32x2*)(a->ws + WS_SDST)};
              pg8::gemm_phase<EpiDown, ExpertOrderDown, true>(lds, lds + XOFF_LDS, 128, S, E); }
#endif
#ifndef NO9B
            { KArgs a = kargs();
              const LAS int* tab = (const LAS int*)(lds + TAB_OFF);
              pg8::DenseOrder S; S.init((const bf16_t*)(a->ws + WS_HMID + (size_t)tab[256] * 256 * 256), (const bf16_t*)(a->ws + WS_ED + (size_t)256 * 1024 * 256), T, 1024, 128, G, (int)blockIdx.x);
              EpiFp8Plain E{(unsigned char*)(a->ws + WS_YSH), Y_SCALE * W8_INV / H8_SCALE};
              pg8::gemm_phase<EpiFp8Plain, pg8::DenseOrder, true>(lds, lds + XOFF_LDS, 128, S, E); }
#endif
        }
        SEAM(pb + 9);
        if (EN(10) && IN(pb + 10)) {
            PH_IDS
            float* H = a->out; bf16_t* HB = (bf16_t*)(a->ws + WS_HB);
            const unsigned char* Y = (const unsigned char*)(a->ws + WS_Y);
            for (int m = gw; m < T; m += 2 * ngw) { const int m2 = m + ngw < T ? m + ngw : m;
                int ya[32], yb[32]; u32x2 ha[4], hb[4]; int sa[4], sb[4];
#pragma unroll
                for (int j = 0; j < 4; ++j) { ha[j] = *(const u32x2*)(HB + (size_t)m * 1024 + 4 * lane + 256 * j); sa[j] = *(const int*)((const unsigned char*)(a->ws + WS_YSH) + (size_t)m * 1024 + 4 * lane + 256 * j); }
#pragma unroll
                for (int k = 0; k < 8; ++k)
#pragma unroll
                    for (int j = 0; j < 4; ++j) ya[4 * k + j] = __builtin_nontemporal_load((const int*)(Y + ((size_t)m * 8 + k) * 1024 + 4 * lane + 256 * j));
#pragma unroll
                for (int j = 0; j < 4; ++j) { hb[j] = *(const u32x2*)(HB + (size_t)m2 * 1024 + 4 * lane + 256 * j); sb[j] = *(const int*)((const unsigned char*)(a->ws + WS_YSH) + (size_t)m2 * 1024 + 4 * lane + 256 * j); }
#pragma unroll
                for (int k = 0; k < 8; ++k)
#pragma unroll
                    for (int j = 0; j < 4; ++j) yb[4 * k + j] = __builtin_nontemporal_load((const int*)(Y + ((size_t)m2 * 8 + k) * 1024 + 4 * lane + 256 * j));
#pragma unroll
                for (int r = 0; r < 2; ++r) { const int mm = r ? m2 : m; f32x4 v[4];
#pragma unroll
                    for (int j = 0; j < 4; ++j) { const u32x2 h2 = r ? hb[j] : ha[j]; const int s8 = r ? sb[j] : sa[j];
                        const f32x2 slo = __builtin_amdgcn_cvt_pk_f32_fp8(s8, false), shi = __builtin_amdgcn_cvt_pk_f32_fp8(s8, true);
                        f32x4 ys = (f32x4){0.f, 0.f, 0.f, 0.f};
#pragma unroll
                        for (int k = 0; k < 8; ++k) { const int y = r ? yb[4 * k + j] : ya[4 * k + j];
                            const f32x2 lo = __builtin_amdgcn_cvt_pk_f32_fp8(y, false), hi2 = __builtin_amdgcn_cvt_pk_f32_fp8(y, true);
                            ys.x += lo.x; ys.y += lo.y; ys.z += hi2.x; ys.w += hi2.y; }
                        v[j] = (f32x4){bflo(h2.x), bfhi(h2.x), bflo(h2.y), bfhi(h2.y)} * ALPHA + (f32x4){slo.x, slo.y, shi.x, shi.y} * (1.0f / 32.0f) + ys * (1.0f / Y_SCALE); }
                    ln_store(v, a->in[I_L2G] + l * 1024, a->in[I_L2B] + l * 1024, (l + 1 < DEPTH) ? nullptr : H + (size_t)mm * 1024, (l + 1 < DEPTH) ? HB + (size_t)mm * 1024 : nullptr, (l + 1 < DEPTH) ? (unsigned char*)(a->ws + WS_HB8) + (size_t)mm * 1024 : nullptr, lane); } }
        }
        SEAM(pb + 10);
    }
#undef IN
#undef SEAM
}

extern "C" void kernel_launch(void* const* d_in, const int* in_sizes, int n_in, void* d_out, int out_size, void* d_ws, size_t ws_size, hipStream_t stream) {
    static int grid = 0;
    if (grid == 0) {
        if (n_in != 26 || out_size != T * 1024 || ws_size < WS_END) { fprintf(stderr, "kernel_launch: unexpected shapes / workspace (n_in %d out %d ws %zu, need %zu)\n", n_in, out_size, ws_size, (size_t)WS_END); grid = -1; return; }
        int dev = 0, cus = 0, per_cu = 0;
        if (hipGetDevice(&dev) != hipSuccess || hipDeviceGetAttribute(&cus, hipDeviceAttributeMultiprocessorCount, dev) != hipSuccess) { grid = -1; return; }
        if (hipFuncSetAttribute((const void*)mega_fwd, hipFuncAttributeMaxDynamicSharedMemorySize, LDS_BYTES) != hipSuccess) { grid = -1; return; }
        if (hipOccupancyMaxActiveBlocksPerMultiprocessor(&per_cu, (const void*)mega_fwd, NWAVES * 64, LDS_BYTES) != hipSuccess || per_cu < 1) { fprintf(stderr, "kernel_launch: occupancy query says %d\n", per_cu); }
        (void)hipGetLastError();
        grid = cus;
    }
    if (grid < 0) return;
    (void)hipMemsetAsync((char*)d_ws + WS_CTL, 0, CTL_ZERO_BYTES, stream);
    Args a{};
    for (int i = 0; i < 26; ++i) a.in[i] = (const float*)d_in[i];
    a.out = (float*)d_out; a.ws = (unsigned char*)d_ws;
#if MK_ONE_LAUNCH
    a.ph_lo = 0; a.ph_hi = NPHASE;
    hipLaunchKernelGGL(mega_fwd, dim3(grid), dim3(NWAVES * 64), LDS_BYTES, stream, a);
#else
    for (int p = 0; p < NPHASE; ++p) { a.ph_lo = p; a.ph_hi = p + 1; hipLaunchKernelGGL(mega_fwd, dim3(grid), dim3(NWAVES * 64), LDS_BYTES, stream, a); }
#endif
}
```

```cpp
#include <hip/hip_runtime.h>
#include <cstdio>
#include <cstdint>

#ifndef MK_ONE_LAUNCH
#define MK_ONE_LAUNCH 1
#endif

#define LAS __attribute__((address_space(3)))
#define GAS __attribute__((address_space(1)))
typedef unsigned short bf16_t;
typedef short bf16x8 __attribute__((ext_vector_type(8)));
typedef short s16x4 __attribute__((ext_vector_type(4)));
typedef float f32x4 __attribute__((ext_vector_type(4)));
typedef float f32x2 __attribute__((ext_vector_type(2)));
typedef float f32x16 __attribute__((ext_vector_type(16)));
typedef unsigned u32x4 __attribute__((ext_vector_type(4)));
typedef unsigned u32x2 __attribute__((ext_vector_type(2)));

constexpr int BATCH = 32, SEQ = 2048, DM = 1024, T = BATCH * SEQ, DEPTH = 2;
constexpr int NCOL = 6656;
constexpr int NEXP = 256, TOPK = 8, EDIM = 256, NEXPS = NEXP + 1;
constexpr float LN_EPS = 1e-5f;
constexpr float ALPHA = 1.4142135623730951f;
constexpr float LOG2E = 1.4426950408889634f;
constexpr float ROUTE_SCALE = 2.5f;
constexpr int NSLOT_MAX = T * TOPK + NEXP * 256;
constexpr int NSLOT_ALL = NSLOT_MAX + T;

constexpr size_t MiB = 1u << 20;
constexpr size_t WS_CTL = 0, CTL_ZERO_BYTES = 1 * MiB;
constexpr size_t WS_WIN = 2 * MiB;
constexpr size_t WS_WPA = 28 * MiB;
constexpr size_t WS_WPB = 32 * MiB;
constexpr size_t WS_WOUT = 34 * MiB;
constexpr size_t WS_WR = 38 * MiB;
constexpr size_t WS_REIDX = 40 * MiB;
constexpr size_t WS_RPOS = 42 * MiB;
constexpr size_t WS_RW = 44 * MiB;
constexpr size_t WS_STOK = 46 * MiB;
constexpr size_t WS_SDST = 49 * MiB;
constexpr size_t WS_SW = 52 * MiB;
constexpr size_t WS_LOGIT = 56 * MiB;
constexpr size_t WS_HB = 120 * MiB;
constexpr size_t WS_EGU = 248 * MiB;
constexpr size_t WS_ED = 505 * MiB;
constexpr size_t WS_BIG = 636 * MiB;
constexpr size_t WS_QA = WS_BIG, WS_KA = WS_BIG + 128 * MiB, WS_VA = WS_BIG + 256 * MiB;
constexpr size_t WS_QN = WS_BIG + 384 * MiB, WS_KN = WS_BIG + 448 * MiB, WS_VN = WS_BIG + 512 * MiB;
constexpr size_t WS_GA = WS_BIG + 576 * MiB, WS_GB = WS_BIG + 704 * MiB;
constexpr size_t WS_MIX = WS_QA;
constexpr size_t WS_YSH = WS_EGU;
constexpr size_t WS_OA8 = WS_BIG + 832 * MiB, WS_OB8 = WS_BIG + 896 * MiB, WS_U8 = WS_BIG + 928 * MiB;
constexpr size_t WS_U = WS_KA;
constexpr size_t WS_HMID = WS_BIG;
constexpr size_t WS_Y = WS_BIG + 320 * MiB;
constexpr size_t WS_HB8 = WS_Y + 1024 * MiB;
constexpr size_t WS_END = WS_HB8 + 64 * MiB;
static_assert((size_t)NSLOT_ALL * 512 <= 320 * MiB, "hmid");
static_assert((size_t)NSLOT_MAX * 4 <= 3 * MiB, "slots");
constexpr int CW_TMO = 0;
constexpr int CW_BAR = 4096;
constexpr int CW_CNT = 16384;
constexpr int CW_ERR = 20000;

constexpr int RING_BYTES = 131072;
constexpr int MISC_OFF = RING_BYTES;
constexpr int TAB_OFF = MISC_OFF + 1024;
constexpr int XOFF_LDS = RING_BYTES + 8192;
constexpr int LDS_BYTES = 147456;

__device__ __forceinline__ unsigned f2bf(float f) { unsigned u = __builtin_bit_cast(unsigned, f); return (u + 0x7fffu + ((u >> 16) & 1u)) >> 16; }
__device__ __forceinline__ unsigned pk2(float lo, float hi) { return f2bf(lo) | (f2bf(hi) << 16); }
__device__ __forceinline__ float bf2f(unsigned short b) { return __builtin_bit_cast(float, (unsigned)b << 16); }
__device__ __forceinline__ float bflo(unsigned w) { return __builtin_bit_cast(float, w << 16); }
__device__ __forceinline__ float bfhi(unsigned w) { return __builtin_bit_cast(float, w & 0xffff0000u); }
typedef __bf16 bf16x2_t __attribute__((ext_vector_type(2)));
typedef int i32x4 __attribute__((ext_vector_type(4)));
typedef int i32x8 __attribute__((ext_vector_type(8)));
__device__ __forceinline__ unsigned cvt_pk_bf16(float lo, float hi) { const f32x2 v = {lo, hi}; const bf16x2_t b = __builtin_convertvector(v, bf16x2_t); return __builtin_bit_cast(unsigned, b); }
__device__ __forceinline__ float fast_sigmoid(float x) { return __builtin_amdgcn_rcpf(1.0f + __builtin_amdgcn_exp2f(-x * LOG2E)); }

namespace pg8 {
constexpr int BM = 256, BK = 64, HALF = 128, HTB = HALF * BK * 2, STAGE_BYTES = 8 * HTB, NXCD = 8, WGM = 8;
__host__ __device__ __forceinline__ int lds_byte(int r, int c) { const int st = (r >> 4) * 2 + (c >> 5), rr = r & 15, cc = c & 31, ob = rr * 64 + cc * 2; return st * 1024 + (ob ^ (((ob >> 9) & 1) << 5)); }
__host__ __device__ __forceinline__ void stage_rc(int b, int& R, int& C) { const int st = b / 1024, sb = b % 1024, swz = sb ^ (((sb >> 9) & 1) << 5); R = (st >> 1) * 16 + swz / 64; C = (st & 1) * 32 + (swz % 64) / 2; }
__host__ __device__ __forceinline__ int perm32(int rho) { const int n = rho >> 4, i = rho & 15; return 8 * (i >> 2) + 4 * n + (i & 3); }

struct Unit { int pm, pn, e, row0; };

struct DenseOrder {
    static constexpr bool GATHER = false;
    int nM, nN, nwg, G, c; const bf16_t* A; const bf16_t* Bt; int K;
    __device__ void init(const bf16_t* A_, const bf16_t* Bt_, int M, int N, int K_, int G_, int c_) { A = A_; Bt = Bt_; K = K_; nM = M / BM; nN = N / BM; nwg = nM * nN; G = G_; c = c_; }
    __device__ __forceinline__ bool next(int i, Unit& u) const {
        const long L = (long)i * G + c; if (L >= nwg) return false;
        int wgid = (int)L; { const int q = nwg / NXCD, r = nwg % NXCD, xcd = wgid % NXCD, off = wgid / NXCD; wgid = (xcd < r ? xcd * (q + 1) : r * (q + 1) + (xcd - r) * q) + off; }
        const int nig = WGM * nN, gid = wgid / nig, fm = gid * WGM, gsz = (nM - fm) < WGM ? (nM - fm) : WGM;
        u.pm = fm + ((wgid % nig) % gsz); u.pn = (wgid % nig) / gsz; u.e = 0; u.row0 = u.pm * BM; return true;
    }
    __device__ __forceinline__ const char* a_base() const { return (const char*)A; }
    __device__ __forceinline__ unsigned a_row(const Unit& u, int r) const { return (unsigned)(u.row0 + r); }
    __device__ __forceinline__ const char* b_tile(const Unit& u) const { return (const char*)Bt + (size_t)u.pn * BM * K * 2; }
};

template <class E, class = void> struct epi_has_prefetch { static constexpr bool value = false; };
template <class E> struct epi_has_prefetch<E, decltype((void)E::PREFETCH)> { static constexpr bool value = true; };
template <class Epi, class Sched, bool F8 = false>
__device__ __forceinline__ void gemm_phase(LAS unsigned char* lds, LAS unsigned char* xlds, const int K, const Sched& S, const Epi& E) {
    constexpr bool GATHER = Sched::GATHER;
    int tid_ = threadIdx.x; asm volatile("" : "+v"(tid_));
    const int tid = tid_, wid = __builtin_amdgcn_readfirstlane(tid >> 6), lane = tid & 63, wr = wid >> 2, wc = wid & 3, fr = lane & 15, fq = lane >> 4;
    const int nt = K / BK;
    unsigned voffA[2], voffB[2];
#pragma unroll
    for (int i = 0; i < 2; ++i) { int R, C; stage_rc(tid * 16 + i * 8192, R, C); const int Rb = Epi::WIDE16 ? (64 * (R >> 5) + 16 * ((R & 15) >> 2) + 4 * ((R >> 4) & 1) + (R & 3)) : (Epi::PERM ? ((R & ~31) + perm32(R & 31)) : R);
        voffA[i] = (unsigned)(R * K + C) * 2u; voffB[i] = (unsigned)(Rb * K + C) * 2u; }
    const size_t kstep = (size_t)(BK * 2);
    const size_t hstep = (size_t)HALF * K * 2;
    const size_t bhs = Epi::WIDE16 ? (size_t)8 * K * 2 : hstep;
    const unsigned rowb = (unsigned)K * 2u;
    const unsigned ldsw = (unsigned)wid * 1024u;
    const int aoff = lds_byte(wr * 64 + fr, fq * 8), boff = lds_byte(wc * 32 + fr, fq * 8);
    LAS u32x4* myx = (LAS u32x4*)(xlds + tid * 16);
#define PG8_SA(b, h) (((b) * 2 + (h)) * HTB)
#define PG8_SB(b, h) ((4 + (b) * 2 + (h)) * HTB)
#define PG8_STAGE(bufoff, gbase, voff) do { _Pragma("unroll") for (int _i = 0; _i < 2; ++_i) \
        __builtin_amdgcn_global_load_lds((const unsigned*)((const char*)(gbase) + (voff)[_i]), (LAS unsigned*)(lds + (bufoff) + ldsw + _i * 8192), 16, 0, 0); } while (0)
#define PG8_STAGE_A(bufoff, dbase, gkt, vv, h) do { if constexpr (GATHER) { PG8_STAGE(bufoff, gkt, (vv)[h]); } else { PG8_STAGE(bufoff, (dbase) + (h) * hstep, voffA); } } while (0)
#define PG8_LD8(p) __builtin_shufflevector(*(const LAS i32x4*)(p), *(const LAS i32x4*)((p) + 1024), 0, 1, 2, 3, 4, 5, 6, 7)
#define PG8_LDA(dst, b, h) do { _Pragma("unroll") for (int m = 0; m < 4; ++m) dst[m] = PG8_LD8(lds + PG8_SA(b, h) + aoff + m * 2048); } while (0)
#define PG8_LDB(dst, b, h) do { _Pragma("unroll") for (int n = 0; n < 2; ++n) dst[n] = PG8_LD8(lds + PG8_SB(b, h) + boff + n * 2048); } while (0)
#define PG8_LO(v) __builtin_bit_cast(bf16x8, __builtin_shufflevector(v, v, 0, 1, 2, 3))
#define PG8_HI(v) __builtin_bit_cast(bf16x8, __builtin_shufflevector(v, v, 4, 5, 6, 7))
#define PG8_MMA(ai, bj, At, Bt) do { __builtin_amdgcn_s_setprio(1); _Pragma("unroll") for (int m = 0; m < 4; ++m) _Pragma("unroll") for (int n = 0; n < 2; ++n) { \
        if constexpr (F8) asm volatile("v_mfma_f32_16x16x128_f8f6f4 %0, %1, %2, %0" : "+v"(acc[ai][bj][m][n]) : "v"(Bt[n]), "v"(At[m])); \
        else { acc[ai][bj][m][n] = __builtin_amdgcn_mfma_f32_16x16x32_bf16(PG8_LO(Bt[n]), PG8_LO(At[m]), acc[ai][bj][m][n], 0, 0, 0); \
               acc[ai][bj][m][n] = __builtin_amdgcn_mfma_f32_16x16x32_bf16(PG8_HI(Bt[n]), PG8_HI(At[m]), acc[ai][bj][m][n], 0, 0, 0); } } __builtin_amdgcn_s_setprio(0); } while (0)
#define PG8_WAIT_V(n) asm volatile("s_waitcnt vmcnt(" #n ")" ::: "memory")
#define PG8_WAIT_L(n) asm volatile("s_waitcnt lgkmcnt(" #n ")" ::: "memory")
#define PG8_BAR __builtin_amdgcn_s_barrier()
#define PG8_SCHED __builtin_amdgcn_sched_barrier(0)
    Unit cur, nxt; int ui = 0;
    if (!S.next(0, cur)) return;
    f32x4 acc[2][2][4][2];
#pragma unroll
    for (int a = 0; a < 2; ++a)
#pragma unroll
        for (int b = 0; b < 2; ++b)
#pragma unroll
            for (int m = 0; m < 4; ++m)
#pragma unroll
                for (int n = 0; n < 2; ++n) acc[a][b][m][n] = (f32x4){0.f, 0.f, 0.f, 0.f};
    i32x8 At[4], B0[2], B1[2];
    const char* const Abase = S.a_base();
    unsigned vc[2][2];
    if constexpr (GATHER) {
#pragma unroll
        for (int h = 0; h < 2; ++h)
#pragma unroll
            for (int i = 0; i < 2; ++i) { int R, C; stage_rc(tid * 16 + i * 8192, R, C); vc[h][i] = S.a_row(cur, h * HALF + R) * rowb + (unsigned)(C * 2); }
    } else { vc[0][0] = vc[0][1] = vc[1][0] = vc[1][1] = 0u; }
    const char* cA = GATHER ? Abase : Abase + (size_t)cur.row0 * rowb;
    const char* cB = S.b_tile(cur);
    PG8_STAGE(PG8_SB(0, 0), cB, voffB); PG8_STAGE(PG8_SB(0, 1), cB + bhs, voffB); PG8_STAGE_A(PG8_SA(0, 0), cA, Abase, vc, 0); PG8_STAGE_A(PG8_SA(0, 1), cA, Abase, vc, 1);
    if (wr == 1) PG8_BAR;
    PG8_WAIT_V(2); PG8_BAR;
    PG8_STAGE(PG8_SB(1, 0), cB + kstep, voffB); PG8_STAGE_A(PG8_SA(1, 0), cA + kstep, Abase + kstep, vc, 0); PG8_STAGE(PG8_SB(1, 1), cB + bhs + kstep, voffB);
    PG8_WAIT_V(6); PG8_BAR;
    for (;;) {
        const bool has_next = S.next(ui + 1, nxt);
        const char* nA = cA; const char* nB = cB;
        if (has_next) { nB = S.b_tile(nxt); if constexpr (!GATHER) nA = Abase + (size_t)nxt.row0 * rowb; }
        if constexpr (GATHER) {
            if (has_next) S.prefetch_rows(nxt, xlds + 4096 + ((ui + 1) & 1) * 2048, tid, wid);
        }
        if constexpr (epi_has_prefetch<Epi>::value) E.prefetch(cur, xlds + (ui & 1) * 2048, tid, wid);
#pragma unroll 1
        for (int t = 0; t < nt; t += 2) {
            const bool last = (t == nt - 2);
            const char* a1 = (GATHER ? Abase : cA) + (size_t)(t + 1) * kstep;
            const char* a2 = last ? (GATHER ? Abase : nA) : (GATHER ? Abase : cA) + (size_t)(t + 2) * kstep; const char* b2 = last ? nB : cB + (size_t)(t + 2) * kstep;
            const char* a3 = a2 + kstep; const char* b3 = b2 + kstep;
            unsigned v2[2][2];
            if constexpr (GATHER) {
                if (last && has_next) { const LAS unsigned char* xb = xlds + 4096 + ((ui + 1) & 1) * 2048; int R0, C0, R1, C1; stage_rc(tid * 16, R0, C0); stage_rc(tid * 16 + 8192, R1, C1);
                    v2[0][0] = S.a_row_lds(nxt, R0, xb) * rowb + (unsigned)(C0 * 2); v2[0][1] = S.a_row_lds(nxt, R1, xb) * rowb + (unsigned)(C1 * 2);
                    v2[1][0] = S.a_row_lds(nxt, HALF + R0, xb) * rowb + (unsigned)(C0 * 2); v2[1][1] = S.a_row_lds(nxt, HALF + R1, xb) * rowb + (unsigned)(C1 * 2); }
                else { v2[0][0] = vc[0][0]; v2[0][1] = vc[0][1]; v2[1][0] = vc[1][0]; v2[1][1] = vc[1][1]; }
            } else { v2[0][0] = v2[0][1] = v2[1][0] = v2[1][1] = 0u; }
            PG8_LDB(B0, 0, 0); PG8_LDB(B1, 0, 1); PG8_SCHED; PG8_LDA(At, 0, 0); PG8_STAGE_A(PG8_SA(1, 1), a1, a1, vc, 1);
            PG8_WAIT_V(8); PG8_WAIT_L(0); PG8_BAR; PG8_MMA(0, 0, At, B0); PG8_MMA(0, 1, At, B1); PG8_BAR; PG8_SCHED;
            PG8_LDA(At, 0, 1); PG8_STAGE(PG8_SB(0, 0), b2, voffB); PG8_STAGE(PG8_SB(0, 1), b2 + bhs, voffB); PG8_STAGE_A(PG8_SA(0, 0), a2, a2, v2, 0);
            PG8_WAIT_V(8); PG8_WAIT_L(0); PG8_BAR; PG8_MMA(1, 0, At, B0); PG8_MMA(1, 1, At, B1); PG8_BAR; PG8_SCHED;
            PG8_LDB(B0, 1, 0); PG8_LDB(B1, 1, 1); PG8_SCHED; PG8_LDA(At, 1, 0); PG8_STAGE_A(PG8_SA(0, 1), a2, a2, v2, 1);
            PG8_WAIT_V(8); PG8_WAIT_L(0); PG8_BAR; PG8_MMA(0, 0, At, B0); PG8_MMA(0, 1, At, B1); PG8_BAR; PG8_SCHED;
            PG8_LDA(At, 1, 1); PG8_STAGE(PG8_SB(1, 0), b3, voffB); PG8_STAGE(PG8_SB(1, 1), b3 + bhs, voffB); PG8_STAGE_A(PG8_SA(1, 0), a3, a3, v2, 0);
            PG8_WAIT_V(8); PG8_WAIT_L(0); PG8_BAR; PG8_MMA(1, 0, At, B0); PG8_MMA(1, 1, At, B1); PG8_BAR; PG8_SCHED;
            if constexpr (GATHER) { if (last) { vc[0][0] = v2[0][0]; vc[0][1] = v2[0][1]; vc[1][0] = v2[1][0]; vc[1][1] = v2[1][1]; } }
        }
        if constexpr (F8) asm volatile("s_nop 15\n\ts_nop 15" ::: "memory");
        if (wr == 0) PG8_BAR;
        if constexpr (epi_has_prefetch<Epi>::value) E(acc, cur, wr, wc, fr, fq, (const LAS unsigned char*)(xlds + (ui & 1) * 2048)); else E(acc, cur, wr, wc, fr, fq);
        if (!has_next) break;
#pragma unroll
        for (int a = 0; a < 2; ++a)
#pragma unroll
            for (int b = 0; b < 2; ++b)
#pragma unroll
                for (int m = 0; m < 4; ++m)
#pragma unroll
                    for (int n = 0; n < 2; ++n) acc[a][b][m][n] = (f32x4){0.f, 0.f, 0.f, 0.f};
        cur = nxt; cA = nA; cB = nB; ++ui;
        if (wr == 1) PG8_BAR;
    }
    PG8_WAIT_V(0);
    PG8_BAR;
#undef PG8_SA
#undef PG8_SB
#undef PG8_STAGE
#undef PG8_STAGE_A
#undef PG8_LDA
#undef PG8_LD8
#undef PG8_LO
#undef PG8_HI
#undef PG8_LDB
#undef PG8_MMA
#undef PG8_WAIT_V
#undef PG8_WAIT_L
#undef PG8_BAR
#undef PG8_SCHED
}
}

using pg8::Unit;
typedef const f32x4 (&AccRef)[2][2][4][2];
constexpr float W8_SCALE = 256.0f, W8_INV = 1.0f / 256.0f;
constexpr float OA8_SCALE = 8.0f, OB8_SCALE = 32.0f, U8_SCALE = 32.0f;
constexpr float QA8_SCALE = 4.0f;
constexpr float G8_SCALE = 256.0f;
constexpr float H8_SCALE = 8.0f;
constexpr float Y_SCALE = 32.0f;

struct EpiInProj {
    static constexpr bool PERM = true, WIDE16 = false;
    unsigned char* ws; const float* bgate;
    __device__ __forceinline__ void operator()(AccRef acc, const Unit& u, int wr, int wc, int fr, int fq) const {
        const int pn = u.pn; size_t off; int ldc, ct; float sc = W8_INV; int gate = -1;
        if (pn < 4) { off = WS_QA; ldc = 1024; ct = pn; sc = 0.125f * LOG2E * W8_INV * QA8_SCALE; }
        else if (pn < 8) { off = WS_KA; ldc = 1024; ct = pn - 4; sc = W8_INV / QA8_SCALE; }
        else if (pn < 12) { off = WS_VA; ldc = 1024; ct = pn - 8; }
        else if (pn < 14) { off = WS_QN; ldc = 512; ct = pn - 12; sc = 0.17677669529663687f * LOG2E * W8_INV; }
        else if (pn < 16) { off = WS_KN; ldc = 512; ct = pn - 14; }
        else if (pn < 18) { off = WS_VN; ldc = 512; ct = pn - 16; }
        else if (pn < 22) { off = WS_GA; ldc = 1024; ct = pn - 18; gate = 0; }
        else { off = WS_GB; ldc = 1024; ct = pn - 22; gate = 1; }
        bf16_t* base = (bf16_t*)(ws + off);
        const int row0 = u.pm * 256 + wr * 64 + fr, col0 = ct * 256 + wc * 32 + 8 * fq;
        if (gate >= 0) {
            f32x4 bv[2][2];
#pragma unroll
            for (int bj = 0; bj < 2; ++bj)
#pragma unroll
                for (int n = 0; n < 2; ++n) bv[bj][n] = *(const f32x4*)(bgate + gate * 1024 + col0 + bj * 128 + 4 * n);
#pragma unroll
            for (int ai = 0; ai < 2; ++ai)
#pragma unroll
                for (int m = 0; m < 4; ++m) { unsigned char* rowp8 = (unsigned char*)base + (size_t)(row0 + ai * 128 + m * 16) * 1024 + col0;
#pragma unroll
                    for (int bj = 0; bj < 2; ++bj) { f32x4 v0 = acc[ai][bj][m][0] * W8_INV + bv[bj][0], v1 = acc[ai][bj][m][1] * W8_INV + bv[bj][1];
#pragma unroll
                        for (int j = 0; j < 4; ++j) { v0[j] = fast_sigmoid(v0[j]) * G8_SCALE; v1[j] = fast_sigmoid(v1[j]) * G8_SCALE; }
                        int p0 = 0, p1 = 0;
                        p0 = __builtin_amdgcn_cvt_pk_fp8_f32(v0[0], v0[1], p0, false); p0 = __builtin_amdgcn_cvt_pk_fp8_f32(v0[2], v0[3], p0, true);
                        p1 = __builtin_amdgcn_cvt_pk_fp8_f32(v1[0], v1[1], p1, false); p1 = __builtin_amdgcn_cvt_pk_fp8_f32(v1[2], v1[3], p1, true);
                        u32x2 w; w.x = (unsigned)p0; w.y = (unsigned)p1; *(u32x2*)(rowp8 + bj * 128) = w; } }
        } else if (pn < 8) {
#pragma unroll
            for (int ai = 0; ai < 2; ++ai)
#pragma unroll
                for (int m = 0; m < 4; ++m) { unsigned char* rowp8 = (unsigned char*)base + (size_t)(row0 + ai * 128 + m * 16) * 1024 + col0;
#pragma unroll
                    for (int bj = 0; bj < 2; ++bj) { const f32x4 v0 = acc[ai][bj][m][0] * sc, v1 = acc[ai][bj][m][1] * sc;
                        int p0 = 0, p1 = 0;
                        p0 = __builtin_amdgcn_cvt_pk_fp8_f32(v0[0], v0[1], p0, false); p0 = __builtin_amdgcn_cvt_pk_fp8_f32(v0[2], v0[3], p0, true);
                        p1 = __builtin_amdgcn_cvt_pk_fp8_f32(v1[0], v1[1], p1, false); p1 = __builtin_amdgcn_cvt_pk_fp8_f32(v1[2], v1[3], p1, true);
                        u32x2 w; w.x = (unsigned)p0; w.y = (unsigned)p1; *(u32x2*)(rowp8 + bj * 128) = w; } }
        } else {
            const bool hm = pn >= 14; const int bjs = hm ? 262144 : 128;
#pragma unroll
            for (int ai = 0; ai < 2; ++ai)
#pragma unroll
                for (int m = 0; m < 4; ++m) { const int row = row0 + ai * 128 + m * 16;
                    bf16_t* rowp = hm ? base + (size_t)(row >> 11) * 1048576 + (size_t)(col0 >> 5) * 65536 + (row & 2047) * 32 + (col0 & 31) : base + (size_t)row * ldc + col0;
#pragma unroll
                    for (int bj = 0; bj < 2; ++bj) { const f32x4 v0 = acc[ai][bj][m][0] * sc, v1 = acc[ai][bj][m][1] * sc;
                        u32x4 w; w.x = cvt_pk_bf16(v0[0], v0[1]); w.y = cvt_pk_bf16(v0[2], v0[3]); w.z = cvt_pk_bf16(v1[0], v1[1]); w.w = cvt_pk_bf16(v1[2], v1[3]);
                        *(u32x4*)(rowp + bj * bjs) = w; } }
        }
    }
};

constexpr float V8_SCALE = 8.0f;
struct EpiVT {
    static constexpr bool PERM = true, WIDE16 = false;
    unsigned char* VT;
    __device__ __forceinline__ void operator()(AccRef acc, const Unit& u, int wr, int wc, int fr, int fq) const {
        const int d0 = u.pm * 256 + wr * 64 + fr, t0 = u.pn * 256 + wc * 32 + 8 * fq;
#pragma unroll
        for (int ai = 0; ai < 2; ++ai)
#pragma unroll
            for (int m = 0; m < 4; ++m) { const int dg = d0 + ai * 128 + m * 16;
#pragma unroll
                for (int bj = 0; bj < 2; ++bj) { const int t = t0 + bj * 128, bb = t >> 11, sq = t & 2047, t6 = sq & 63;
                    unsigned char* p = VT + ((size_t)((bb * 8 + (dg >> 7)) * 128 + (dg & 127)) * 2048) + (sq >> 6) * 64 + 16 * (t6 >> 5) + 4 * ((t6 & 31) >> 3);
                    const f32x4 v0 = acc[ai][bj][m][0] * (W8_INV * V8_SCALE), v1 = acc[ai][bj][m][1] * (W8_INV * V8_SCALE);
                    int p0 = 0, p1 = 0;
                    p0 = __builtin_amdgcn_cvt_pk_fp8_f32(v0[0], v0[1], p0, false); p0 = __builtin_amdgcn_cvt_pk_fp8_f32(v0[2], v0[3], p0, true);
                    p1 = __builtin_amdgcn_cvt_pk_fp8_f32(v1[0], v1[1], p1, false); p1 = __builtin_amdgcn_cvt_pk_fp8_f32(v1[2], v1[3], p1, true);
                    *(int*)p = p0; *(int*)(p + 32) = p1; } }
    }
};
struct InProjOrder : pg8::DenseOrder {
    __device__ __forceinline__ bool next(int i, Unit& u) const { if (!pg8::DenseOrder::next(i, u)) return false; if (u.pn >= 8) u.pn += 4; return true; }
};

template <bool ADD> struct EpiProj {
    static constexpr bool PERM = true, WIDE16 = false;
    bf16_t* U; const unsigned char* G; unsigned char* U8; float asc;
    __device__ __forceinline__ void operator()(AccRef acc, const Unit& u, int wr, int wc, int fr, int fq) const {
        const int row0 = u.pm * 256 + wr * 64 + fr, col0 = u.pn * 256 + wc * 32 + 8 * fq;
#pragma unroll
        for (int ai = 0; ai < 2; ++ai) {
            u32x2 g[4][2]; u32x4 o[4][2];
#pragma unroll
            for (int m = 0; m < 4; ++m)
#pragma unroll
                for (int bj = 0; bj < 2; ++bj) { const size_t ro = (size_t)(row0 + ai * 128 + m * 16) * 1024 + col0 + bj * 128; g[m][bj] = *(const u32x2*)(G + ro);
                    if (ADD) o[m][bj] = *(const u32x4*)(U + ro); }
#pragma unroll
            for (int m = 0; m < 4; ++m)
#pragma unroll
                for (int bj = 0; bj < 2; ++bj) { const size_t ro = (size_t)(row0 + ai * 128 + m * 16) * 1024 + col0 + bj * 128; const f32x4 v0 = acc[ai][bj][m][0] * asc, v1 = acc[ai][bj][m][1] * asc; const u32x2 gg = g[m][bj];
                    const f32x2 g0 = __builtin_amdgcn_cvt_pk_f32_fp8((int)gg.x, false), g1 = __builtin_amdgcn_cvt_pk_f32_fp8((int)gg.x, true), g2 = __builtin_amdgcn_cvt_pk_f32_fp8((int)gg.y, false), g3 = __builtin_amdgcn_cvt_pk_f32_fp8((int)gg.y, true);
                    float r[8];
                    r[0] = g0.x * v0[0]; r[1] = g0.y * v0[1]; r[2] = g1.x * v0[2]; r[3] = g1.y * v0[3];
                    r[4] = g2.x * v1[0]; r[5] = g2.y * v1[1]; r[6] = g3.x * v1[2]; r[7] = g3.y * v1[3];
                    if (ADD) { const u32x4 oo = o[m][bj];
                        r[0] += bflo(oo.x); r[1] += bfhi(oo.x); r[2] += bflo(oo.y); r[3] += bfhi(oo.y); r[4] += bflo(oo.z); r[5] += bfhi(oo.z); r[6] += bflo(oo.w); r[7] += bfhi(oo.w);
                        int p0 = 0, p1 = 0;
                        p0 = __builtin_amdgcn_cvt_pk_fp8_f32(r[0] * U8_SCALE, r[1] * U8_SCALE, p0, false); p0 = __builtin_amdgcn_cvt_pk_fp8_f32(r[2] * U8_SCALE, r[3] * U8_SCALE, p0, true);
                        p1 = __builtin_amdgcn_cvt_pk_fp8_f32(r[4] * U8_SCALE, r[5] * U8_SCALE, p1, false); p1 = __builtin_amdgcn_cvt_pk_fp8_f32(r[6] * U8_SCALE, r[7] * U8_SCALE, p1, true);
                        u32x2 w; w.x = (unsigned)p0; w.y = (unsigned)p1; *(u32x2*)(U8 + ro) = w; }
                    else { u32x4 w; w.x = cvt_pk_bf16(r[0], r[1]); w.y = cvt_pk_bf16(r[2], r[3]); w.z = cvt_pk_bf16(r[4], r[5]); w.w = cvt_pk_bf16(r[6], r[7]);
                        *(u32x4*)(U + ro) = w; } }
            asm volatile("" ::: "memory"); }
    }
};

struct EpiResid {
    static constexpr bool PERM = false, WIDE16 = false;
    float* H;
    __device__ __forceinline__ void operator()(AccRef acc, const Unit& u, int wr, int wc, int fr, int fq) const {
        const int row0 = u.row0 + wr * 64 + fr, col0 = u.pn * 256 + wc * 32 + 4 * fq;
#pragma unroll
        for (int ai = 0; ai < 2; ++ai)
#pragma unroll
            for (int m = 0; m < 4; ++m) { float* rowp = H + (size_t)(row0 + ai * 128 + m * 16) * 1024 + col0;
#pragma unroll
                for (int bj = 0; bj < 2; ++bj)
#pragma unroll
                    for (int n = 0; n < 2; ++n) { const f32x4 h = *(const f32x4*)(rowp + bj * 128 + n * 16); *(f32x4*)(rowp + bj * 128 + n * 16) = h * ALPHA + acc[ai][bj][m][n]; }
                asm volatile("" ::: "memory"); }
    }
};

struct EpiFp8Plain {
    static constexpr bool PERM = true, WIDE16 = true;
    unsigned char* O; float osc;
    __device__ __forceinline__ void operator()(AccRef acc, const Unit& u, int wr, int wc, int fr, int fq) const {
        const int row0 = u.row0 + wr * 64 + fr, col0 = u.pn * 256 + wc * 64 + 16 * fq;
#pragma unroll
        for (int ai = 0; ai < 2; ++ai)
#pragma unroll
            for (int m = 0; m < 4; ++m) { u32x4 w;
#pragma unroll
                for (int bj = 0; bj < 2; ++bj)
#pragma unroll
                    for (int n = 0; n < 2; ++n) { const f32x4 v = acc[ai][bj][m][n] * osc; int p = 0;
                        p = __builtin_amdgcn_cvt_pk_fp8_f32(v[0], v[1], p, false); p = __builtin_amdgcn_cvt_pk_fp8_f32(v[2], v[3], p, true); w[2 * bj + n] = (unsigned)p; }
                *(u32x4*)(O + (size_t)(row0 + ai * 128 + m * 16) * 1024 + col0) = w; }
    }
};

struct EpiF32 {
    static constexpr bool PERM = false, WIDE16 = false;
    float* C; int ldc;
    __device__ __forceinline__ void operator()(AccRef acc, const Unit& u, int wr, int wc, int fr, int fq) const {
        const int row0 = u.pm * 256 + wr * 64 + fr, col0 = u.pn * 256 + wc * 32 + 4 * fq;
#pragma unroll
        for (int ai = 0; ai < 2; ++ai)
#pragma unroll
            for (int m = 0; m < 4; ++m) { float* rowp = C + (size_t)(row0 + ai * 128 + m * 16) * ldc + col0;
#pragma unroll
                for (int bj = 0; bj < 2; ++bj)
#pragma unroll
                    for (int n = 0; n < 2; ++n) *(f32x4*)(rowp + bj * 128 + n * 16) = acc[ai][bj][m][n]; }
    }
};

struct EpiF32T {
    static constexpr bool PERM = false, WIDE16 = false;
    float* CT; int ldr;
    __device__ __forceinline__ void operator()(AccRef acc, const Unit& u, int wr, int wc, int fr, int fq) const {
        const int row0 = u.pm * 256 + wr * 64 + fr, col0 = u.pn * 256 + wc * 32 + 4 * fq;
#pragma unroll
        for (int ai = 0; ai < 2; ++ai)
#pragma unroll
            for (int m = 0; m < 4; ++m) { float* base = CT + (size_t)col0 * ldr + (row0 + ai * 128 + m * 16);
#pragma unroll
                for (int bj = 0; bj < 2; ++bj)
#pragma unroll
                    for (int n = 0; n < 2; ++n)
#pragma unroll
                        for (int j = 0; j < 4; ++j) base[(size_t)(bj * 128 + n * 16 + j) * ldr] = acc[ai][bj][m][n][j]; }
    }
};

struct EpiSwiglu {
    static constexpr bool PERM = true, WIDE16 = false;
    unsigned char* Hm;
    __device__ __forceinline__ void operator()(AccRef acc, const Unit& u, int wr, int wc, int fr, int fq) const {
        const int row0 = u.pm * 256 + wr * 64 + fr, col0 = u.pn * 128 + wc * 32 + 8 * fq;
#pragma unroll
        for (int ai = 0; ai < 2; ++ai)
#pragma unroll
            for (int m = 0; m < 4; ++m) { unsigned char* rowp = Hm + (size_t)(row0 + ai * 128 + m * 16) * 256 + col0;
                float r[8];
#pragma unroll
                for (int n = 0; n < 2; ++n)
#pragma unroll
                    for (int j = 0; j < 4; ++j) { const float g = acc[ai][0][m][n][j] * W8_INV, up = acc[ai][1][m][n][j] * (W8_INV * H8_SCALE); r[4 * n + j] = g * fast_sigmoid(g) * up; }
                int p0 = 0, p1 = 0;
                p0 = __builtin_amdgcn_cvt_pk_fp8_f32(r[0], r[1], p0, false); p0 = __builtin_amdgcn_cvt_pk_fp8_f32(r[2], r[3], p0, true);
                p1 = __builtin_amdgcn_cvt_pk_fp8_f32(r[4], r[5], p1, false); p1 = __builtin_amdgcn_cvt_pk_fp8_f32(r[6], r[7], p1, true);
                u32x2 w; w.x = (unsigned)p0; w.y = (unsigned)p1; *(u32x2*)rowp = w; }
    }
};

struct EpiDown {
    static constexpr bool PERM = true, WIDE16 = true, PREFETCH = true;
    unsigned char* Y; const u32x2* sinf;
    __device__ __forceinline__ void prefetch(const Unit& u, LAS unsigned char* buf, int tid, int wid) const {
        __builtin_amdgcn_global_load_lds((const unsigned*)(sinf + (size_t)u.pm * 256) + tid, (LAS unsigned*)(buf + wid * 256), 4, 0, 0);
    }
    __device__ __forceinline__ void operator()(AccRef acc, const Unit& u, int wr, int wc, int fr, int fq, const LAS unsigned char* buf) const {
        const int r0 = wr * 64 + fr, col0 = u.pn * 256 + wc * 64 + 16 * fq;
        int dst[8]; float wg[8];
#pragma unroll
        for (int i = 0; i < 8; ++i) { const u32x2 si = *(const LAS u32x2*)(buf + (r0 + (i >> 2) * 128 + (i & 3) * 16) * 8); const unsigned sx = si.x, sy = si.y; dst[i] = (int)sx; wg[i] = __uint_as_float(sy); }
#pragma unroll
        for (int ai = 0; ai < 2; ++ai)
#pragma unroll
            for (int m = 0; m < 4; ++m) { const int d = dst[ai * 4 + m]; const float wgt = wg[ai * 4 + m] * (Y_SCALE * W8_INV / H8_SCALE);
                if (d >= 0) { u32x4 w;
#pragma unroll
                    for (int bj = 0; bj < 2; ++bj)
#pragma unroll
                        for (int n = 0; n < 2; ++n) { const f32x4 v = acc[ai][bj][m][n] * wgt; int p = 0;
                            p = __builtin_amdgcn_cvt_pk_fp8_f32(v[0], v[1], p, false); p = __builtin_amdgcn_cvt_pk_fp8_f32(v[2], v[3], p, true); w[2 * bj + n] = (unsigned)p; }
                    *(u32x4*)(Y + (size_t)d * 1024 + col0) = w; } }
    }
};

__device__ __forceinline__ int tab_find(const LAS int* tab, int pm) {
    int lo = 0, hi = 256;
    while (lo < hi) { const int mid = (lo + hi + 1) >> 1; if (tab[mid] <= pm) lo = mid; else hi = mid - 1; }
    return lo;
}
__device__ __forceinline__ int xcd_remap(int L, int nwg) { const int q = nwg / 8, r = nwg % 8, xcd = L % 8, off = L / 8; return (xcd < r ? xcd * (q + 1) : r * (q + 1) + (xcd - r) * q) + off; }

struct ExpertOrderGU {
    static constexpr bool GATHER = true;
    const LAS int* tab; const bf16_t* A; const bf16_t* W; const int* stok; int G, c, nwg;
    __device__ __forceinline__ bool next(int i, Unit& u) const {
        const long L = (long)i * G + c; if (L >= nwg) return false;
        const int id = xcd_remap((int)L, nwg);
        u.pm = id >> 1; u.pn = id & 1; u.e = __builtin_amdgcn_readfirstlane(tab_find(tab, u.pm)); u.row0 = (u.pm - tab[256]) * 256; return true;
    }
    __device__ __forceinline__ const char* a_base() const { return (const char*)A; }
    __device__ __forceinline__ unsigned a_row(const Unit& u, int r) const { return u.e == 256 ? (unsigned)(u.row0 + r) : (unsigned)stok[u.pm * 256 + r]; }
    __device__ __forceinline__ void prefetch_rows(const Unit& u, LAS unsigned char* buf, int tid, int wid) const {
        if (u.e != 256) __builtin_amdgcn_global_load_lds((const unsigned*)(stok + (size_t)u.pm * 256) + (tid & 255), (LAS unsigned*)(buf + wid * 256), 4, 0, 0);
    }
    __device__ __forceinline__ unsigned a_row_lds(const Unit& u, int r, const LAS unsigned char* buf) const { return u.e == 256 ? (unsigned)(u.row0 + r) : ((const LAS unsigned*)buf)[r]; }
    __device__ __forceinline__ const char* b_tile(const Unit& u) const { return (const char*)W + ((size_t)u.e * 512 + (size_t)u.pn * 256) * 1024; }
};
struct ExpertOrderDown {
    static constexpr bool GATHER = false;
    const LAS int* tab; const bf16_t* A; const bf16_t* W; int G, c, nwg;
    __device__ __forceinline__ bool next(int i, Unit& u) const {
        const long L = (long)i * G + c; if (L >= nwg) return false;
        const int id = xcd_remap((int)L, nwg);
        u.pm = id >> 2; u.pn = id & 3; u.e = __builtin_amdgcn_readfirstlane(tab_find(tab, u.pm)); u.row0 = u.pm * 256; return true;
    }
    __device__ __forceinline__ const char* a_base() const { return (const char*)A; }
    __device__ __forceinline__ unsigned a_row(const Unit& u, int r) const { return (unsigned)(u.row0 + r); }
    __device__ __forceinline__ const char* b_tile(const Unit& u) const { return (const char*)W + ((size_t)u.e * 1024 + (size_t)u.pn * 256) * 256; }
};

#define XB_TMO      128
#define XB_XCNT(j)  (256  + 64 * (j))
#define XB_XSUB(j)  (1280 + 64 * (j))
#define XB_XGEN(j)  (2304 + 64 * (j))
#define XB_TOP      3328
#define XB_TOPGEN   3392
#define XCD_BAR_WORDS 3456
#define XB_SPIN_CAP (1u << 22)
__device__ __forceinline__ unsigned xb_ld(unsigned* p)              { return __hip_atomic_load(p, __ATOMIC_RELAXED, __HIP_MEMORY_SCOPE_AGENT); }
__device__ __forceinline__ unsigned xb_add(unsigned* p, unsigned v) { return __hip_atomic_fetch_add(p, v, __ATOMIC_RELAXED, __HIP_MEMORY_SCOPE_AGENT); }
__device__ __forceinline__ unsigned xb_xcc_id() { return (unsigned)__builtin_amdgcn_s_getreg((3 << 11) | 20) & 0xFu; }
#define XB_SPIN(cond, bar) do { unsigned _sp = 0; while (cond) { __builtin_amdgcn_s_sleep(1); \
    if ((++_sp & 255u) == 0u) { if (xb_ld(&(bar)[XB_TMO])) break; if (_sp > XB_SPIN_CAP) { atomicAdd(&(bar)[XB_TMO], 1u); break; } } } } while (0)
struct XcdBarrier { unsigned* bar; unsigned x; volatile LAS unsigned* st; };
__device__ __forceinline__ XcdBarrier xcd_barrier_post(unsigned* bar, volatile LAS unsigned* st) {
    XcdBarrier b; b.bar = bar; b.x = xb_xcc_id(); b.st = st;
    if (threadIdx.x == 0) (void)xb_add(&bar[XB_XCNT(b.x)], 1u);
    return b;
}
__device__ __forceinline__ void xcd_barrier_complete(unsigned* bar, unsigned x, unsigned& nloc, unsigned& nx) {
    const unsigned G = gridDim.x * gridDim.y * gridDim.z;
    unsigned sum, cnt, mine, sp = 0u;
    for (;;) {
        sum = 0u; cnt = 0u; mine = 0u;
#pragma unroll
        for (unsigned j = 0; j < 16; ++j) { const unsigned c = xb_ld(&bar[XB_XCNT(j)]); sum += c; cnt += (c > 0u) ? 1u : 0u; mine = (j == x) ? c : mine; }
        if (sum == G) break;
        __builtin_amdgcn_s_sleep(1);
        if ((++sp & 255u) == 0u) { if (xb_ld(&bar[XB_TMO])) break; if (sp > XB_SPIN_CAP) { atomicAdd(&bar[XB_TMO], 1u); break; } }
    }
    nloc = mine > 0u ? mine : 1u; nx = cnt > 0u ? cnt : 1u;
}
__device__ __forceinline__ void xcd_barrier(const XcdBarrier& b) {
    asm volatile("s_waitcnt vmcnt(0)" ::: "memory");
    __syncthreads();
    if (threadIdx.x == 0) {
        unsigned* bar = b.bar;
        __builtin_amdgcn_s_waitcnt(0);
        unsigned nloc = b.st[0], nx = b.st[1];
        if (nloc == 0u) { xcd_barrier_complete(bar, b.x, nloc, nx); b.st[0] = nloc; b.st[1] = nx; }
        const unsigned old = xb_add(&bar[XB_XSUB(b.x)], 1u);
        const unsigned gen = old / nloc;
        if (old + 1u == (gen + 1u) * nloc) {
            __builtin_amdgcn_fence(__ATOMIC_RELEASE, "agent");
            asm volatile("s_waitcnt vmcnt(0)" ::: "memory");
            const unsigned og = xb_add(&bar[XB_TOP], 1u);
            const unsigned tg = og / nx;
            if (og + 1u == (tg + 1u) * nx) xb_add(&bar[XB_TOPGEN], 1u);
            else XB_SPIN(xb_ld(&bar[XB_TOPGEN]) == tg, bar);
            __builtin_amdgcn_fence(__ATOMIC_ACQUIRE, "agent");
            xb_add(&bar[XB_XGEN(b.x)], 1u);
            asm volatile("s_waitcnt vmcnt(0)" ::: "memory");
        } else {
            XB_SPIN(xb_ld(&bar[XB_XGEN(b.x)]) == gen, bar);
            __builtin_amdgcn_fence(__ATOMIC_ACQUIRE, "agent");
            asm volatile("s_waitcnt vmcnt(0)" ::: "memory");
        }
    }
    __syncthreads();
}

struct Args { const float* in[26]; float* out; unsigned char* ws; int ph_lo, ph_hi; };
typedef const __attribute__((address_space(4))) Args* KArgs;
__device__ __forceinline__ KArgs kargs() { KArgs p = (KArgs)__builtin_amdgcn_kernarg_segment_ptr(); asm volatile("" : "+s"(p)); return p; }
enum { I_X = 0, I_EG, I_EB, I_WIN, I_BG, I_LQ1, I_LK1, I_LQ2, I_LK2, I_SUBG, I_WPA, I_RPB, I_WPB, I_WOUT, I_L1G, I_L1B, I_RW, I_RB, I_EWG, I_EWU, I_EWD, I_SWG, I_SWU, I_SWD, I_L2G, I_L2B };
constexpr int NWAVES = 8;

__device__ __forceinline__ float wave_sum(float v) {
#pragma unroll
    for (int o = 1; o < 64; o <<= 1) v += __shfl_xor(v, o);
    return v;
}

template <bool F8 = false>
__device__ __forceinline__ void transpose_item(const float* W, int N, int k0, int n0, bf16_t* dst, int Kd, int drow0, LAS float* scr, int lane) {
    float tv[32];
#pragma unroll
    for (int i = 0; i < 32; ++i) { const int kk = 2 * i + (lane >> 5); tv[i] = __builtin_nontemporal_load(W + (size_t)(k0 + kk) * N + n0 + (lane & 31)); }
#pragma unroll
    for (int i = 0; i < 32; ++i) { const int kk = 2 * i + (lane >> 5); scr[kk * 33 + (lane & 31)] = tv[i]; }
    asm volatile("s_waitcnt lgkmcnt(0)" ::: "memory");
    const int c = lane & 7;
#pragma unroll
    for (int j = 0; j < 4; ++j) { const int n = (lane >> 3) + 8 * j; const LAS float* s = scr + (8 * c) * 33 + n;
        if constexpr (F8) { int p0 = 0, p1 = 0;
            p0 = __builtin_amdgcn_cvt_pk_fp8_f32(s[0 * 33] * W8_SCALE, s[1 * 33] * W8_SCALE, p0, false); p0 = __builtin_amdgcn_cvt_pk_fp8_f32(s[2 * 33] * W8_SCALE, s[3 * 33] * W8_SCALE, p0, true);
            p1 = __builtin_amdgcn_cvt_pk_fp8_f32(s[4 * 33] * W8_SCALE, s[5 * 33] * W8_SCALE, p1, false); p1 = __builtin_amdgcn_cvt_pk_fp8_f32(s[6 * 33] * W8_SCALE, s[7 * 33] * W8_SCALE, p1, true);
            u32x2 o; o.x = (unsigned)p0; o.y = (unsigned)p1; *(u32x2*)((unsigned char*)dst + (size_t)(drow0 + n) * Kd + k0 + 8 * c) = o; }
        else { u32x4 o; o.x = pk2(s[0 * 33], s[1 * 33]); o.y = pk2(s[2 * 33], s[3 * 33]); o.z = pk2(s[4 * 33], s[5 * 33]); o.w = pk2(s[6 * 33], s[7 * 33]);
            *(u32x4*)(dst + (size_t)(drow0 + n) * Kd + k0 + 8 * c) = o; } }
    asm volatile("s_waitcnt lgkmcnt(0)" ::: "memory");
}

struct ConvItem { const float* W; unsigned char* dst; int N, k0, n0, Kd, drow0; bool valid; };
__device__ __forceinline__ void conv_load(const ConvItem& d, float (&tv)[32], int lane) {
#pragma unroll
    for (int i = 0; i < 32; ++i) { const int kk = 2 * i + (lane >> 5); tv[i] = __builtin_nontemporal_load(d.W + (size_t)(d.k0 + kk) * d.N + d.n0 + (lane & 31)); }
}
__device__ __forceinline__ void conv_store(const ConvItem& d, const float (&tv)[32], LAS float* scr, int lane) {
#pragma unroll
    for (int i = 0; i < 32; ++i) { const int kk = 2 * i + (lane >> 5); scr[kk * 33 + (lane & 31)] = tv[i]; }
    asm volatile("s_waitcnt lgkmcnt(0)" ::: "memory");
    const int c = lane & 7;
#pragma unroll
    for (int j = 0; j < 4; ++j) { const int n = (lane >> 3) + 8 * j; const LAS float* s = scr + (8 * c) * 33 + n; int p0 = 0, p1 = 0;
        p0 = __builtin_amdgcn_cvt_pk_fp8_f32(s[0 * 33] * W8_SCALE, s[1 * 33] * W8_SCALE, p0, false); p0 = __builtin_amdgcn_cvt_pk_fp8_f32(s[2 * 33] * W8_SCALE, s[3 * 33] * W8_SCALE, p0, true);
        p1 = __builtin_amdgcn_cvt_pk_fp8_f32(s[4 * 33] * W8_SCALE, s[5 * 33] * W8_SCALE, p1, false); p1 = __builtin_amdgcn_cvt_pk_fp8_f32(s[6 * 33] * W8_SCALE, s[7 * 33] * W8_SCALE, p1, true);
        u32x2 o; o.x = (unsigned)p0; o.y = (unsigned)p1; *(u32x2*)(d.dst + (size_t)(d.drow0 + n) * d.Kd + d.k0 + 8 * c) = o; }
    asm volatile("s_waitcnt lgkmcnt(0)" ::: "memory");
}

__device__ __forceinline__ void convert_small(KArgs a, LAS unsigned char* lds, int gw, int ngw, int lane, int wave) {
    LAS float* scr = (LAS float*)(lds + wave * 16384);
    constexpr int PER_L = 3328 + 512 + 256 + 512 + 128;
    for (int it = gw; it < 2 * PER_L; it += ngw) {
        const int l = it / PER_L; int r = it % PER_L;
        if (r < 3328) { const int kb = r / 208, nb = r % 208; transpose_item<true>(a->in[I_WIN] + (size_t)l * 1024 * NCOL, NCOL, 64 * kb, 32 * nb, (bf16_t*)(a->ws + WS_WIN + (size_t)l * NCOL * 1024), 1024, 32 * nb, scr, lane); continue; } r -= 3328;
        if (r < 512) { const int kb = r / 32, nb = r % 32; transpose_item<true>(a->in[I_WPA] + (size_t)l * 1024 * 1024, 1024, 64 * kb, 32 * nb, (bf16_t*)(a->ws + WS_WPA + (size_t)l * 1024 * 1024), 1024, 32 * nb, scr, lane); continue; } r -= 512;
        if (r < 256) { const int kb = r / 32, nb = r % 32; transpose_item<true>(a->in[I_WPB] + (size_t)l * 512 * 1024, 1024, 64 * kb, 32 * nb, (bf16_t*)(a->ws + WS_WPB + (size_t)l * 1024 * 512), 512, 32 * nb, scr, lane); continue; } r -= 256;
        if (r < 512) { const int kb = r / 32, nb = r % 32; transpose_item<true>(a->in[I_WOUT] + (size_t)l * 1024 * 1024, 1024, 64 * kb, 32 * nb, (bf16_t*)(a->ws + WS_WOUT + (size_t)l * 1024 * 1024), 1024, 32 * nb, scr, lane); continue; } r -= 512;
        { const int kb = r / 8, nb = r % 8; transpose_item(a->in[I_RW] + (size_t)l * 1024 * 256, 256, 64 * kb, 32 * nb, (bf16_t*)(a->ws + WS_WR) + (size_t)l * 256 * 1024, 1024, 32 * nb, scr, lane); }
    }
}
constexpr int N_EXP_ITEMS = 771 * 128;
__device__ __forceinline__ ConvItem expert_item(KArgs a, int l, int it) {
    ConvItem d; d.valid = it < N_EXP_ITEMS; if (!d.valid) it = 0;
    const int mat = it >> 7, sub = it & 127;
    if (mat < 512 || mat == 768 || mat == 769) {
        const bool up = (mat >= 256 && mat < 512) || mat == 769; const int e = mat < 256 ? mat : (mat < 512 ? mat - 256 : 256);
        d.W = mat < 256 ? a->in[I_EWG] + ((size_t)l * 256 + e) * 262144 : (mat < 512 ? a->in[I_EWU] + ((size_t)l * 256 + e) * 262144 : (mat == 768 ? a->in[I_SWG] + (size_t)l * 262144 : a->in[I_SWU] + (size_t)l * 262144));
        const int kb = sub >> 3, nb = sub & 7, n0 = 32 * nb;
        d.N = 256; d.k0 = 64 * kb; d.n0 = n0; d.dst = a->ws + WS_EGU + (size_t)e * 512 * 1024; d.Kd = 1024; d.drow0 = (n0 >> 7) * 256 + (n0 & 127) + (up ? 128 : 0);
    } else {
        const int e = mat == 770 ? 256 : mat - 512;
        d.W = mat == 770 ? a->in[I_SWD] + (size_t)l * 262144 : a->in[I_EWD] + ((size_t)l * 256 + e) * 262144;
        const int kb = sub >> 5, nb = sub & 31;
        d.N = 1024; d.k0 = 64 * kb; d.n0 = 32 * nb; d.dst = a->ws + WS_ED + (size_t)e * 1024 * 256; d.Kd = 256; d.drow0 = 32 * nb;
    }
    return d;
}
__device__ __forceinline__ void convert_expert_items3(KArgs a, int l, int it0, int it1, int it2, LAS float* scr, int lane) {
    asm volatile("s_waitcnt vmcnt(0) lgkmcnt(0)\n\ts_nop 15\n\ts_nop 15" ::: "memory");
    const ConvItem d0 = expert_item(a, l, it0), d1 = expert_item(a, l, it1), d2 = expert_item(a, l, it2);
    float t0[32], t1[32], t2[32];
    if (d0.valid) conv_load(d0, t0, lane);
    if (d1.valid) conv_load(d1, t1, lane);
    if (d2.valid) conv_load(d2, t2, lane);
    if (d0.valid) conv_store(d0, t0, scr, lane);
    if (d1.valid) conv_store(d1, t1, scr, lane);
    if (d2.valid) conv_store(d2, t2, scr, lane);
}

__device__ __forceinline__ void ln_store(f32x4 (&v)[4], const float* g, const float* b, float* out32, bf16_t* outb, unsigned char* out8, int lane) {
    float s = 0.f;
#pragma unroll
    for (int j = 0; j < 4; ++j) s += (v[j].x + v[j].y) + (v[j].z + v[j].w);
    const float mean = wave_sum(s) * (1.f / 1024.f); float s2 = 0.f;
#pragma unroll
    for (int j = 0; j < 4; ++j) { v[j] = v[j] - mean; s2 += (v[j].x * v[j].x + v[j].y * v[j].y) + (v[j].z * v[j].z + v[j].w * v[j].w); }
    const float rstd = 1.f / sqrtf(wave_sum(s2) * (1.f / 1024.f) + LN_EPS);
#pragma unroll
    for (int j = 0; j < 4; ++j) { const f32x4 gg = *(const f32x4*)(g + 4 * lane + 256 * j), bb = *(const f32x4*)(b + 4 * lane + 256 * j);
        const f32x4 o = v[j] * rstd * gg + bb;
        if (out32) *(f32x4*)(out32 + 4 * lane + 256 * j) = o;
        if (outb) { u32x2 w; w.x = pk2(o.x, o.y); w.y = pk2(o.z, o.w); *(u32x2*)(outb + 4 * lane + 256 * j) = w; }
        if (out8) { int p = 0; p = __builtin_amdgcn_cvt_pk_fp8_f32(o.x, o.y, p, false); p = __builtin_amdgcn_cvt_pk_fp8_f32(o.z, o.w, p, true); *(int*)(out8 + 4 * lane + 256 * j) = p; } }
}

__device__ __forceinline__ f32x4 ldfp8x4(const unsigned char* p) { const int y = *(const int*)p; const f32x2 lo = __builtin_amdgcn_cvt_pk_f32_fp8(y, false), hi = __builtin_amdgcn_cvt_pk_f32_fp8(y, true); return (f32x4){lo.x, lo.y, hi.x, hi.y} * (1.0f / 32.0f); }
__device__ __forceinline__ f32x4 ldbf4(const bf16_t* p) { const u32x2 y = *(const u32x2*)p; return (f32x4){bflo(y.x), bfhi(y.x), bflo(y.y), bfhi(y.y)}; }

constexpr int AT_KP = 144;
constexpr int AT_KP8 = 80;
constexpr int AT_KB = 64 * AT_KP8;
constexpr int AT_VB = 128 * AT_KP8;
constexpr int AT_K0 = 0, AT_V0 = 2 * AT_KB;
constexpr int AT_O1 = 30720;
constexpr int AT_KN = 96256, AT_RED = 96256 + 128;
typedef short v4i16_t __attribute__((ext_vector_type(4)));
__device__ __forceinline__ s16x4 ds_tr(const LAS unsigned char* p) { return __builtin_bit_cast(s16x4, __builtin_amdgcn_ds_read_tr16_b64_v4i16((LAS v4i16_t*)p)); }
__device__ __forceinline__ bf16x8 cat8(s16x4 a, s16x4 b) { return (bf16x8){a[0], a[1], a[2], a[3], b[0], b[1], b[2], b[3]}; }
#define CROWF(r) ((float)(((r) & 3) + 8 * ((r) >> 2)))
__device__ __forceinline__ float xhalf_max(float v) { const auto r = __builtin_amdgcn_permlane32_swap(__float_as_uint(v), __float_as_uint(v), false, false); return fmaxf(__uint_as_float(r[0]), __uint_as_float(r[1])); }
__device__ __forceinline__ float xhalf_sum(float v) { const auto r = __builtin_amdgcn_permlane32_swap(__float_as_uint(v), __float_as_uint(v), false, false); return __uint_as_float(r[0]) + __uint_as_float(r[1]); }

__device__ __forceinline__ int attn_tile(int i, int qb) {
    const int c0 = 4 * qb; if (i < 4) return c0 + i;
    const int nr = 32 - (c0 + 4), nl = c0, j = i - 4;
    const int pairs = nr < nl ? nr : nl;
    if (j < 2 * pairs) return (j & 1) ? c0 - 1 - (j >> 1) : c0 + 4 + (j >> 1);
    const int k = j - 2 * pairs; return nr > nl ? c0 + 4 + pairs + k : c0 - 1 - pairs - k;
}
__device__ __forceinline__ void diffattn_unit(KArgs a, int l, int b, int h, int qb, float lam, LAS unsigned char* lds, const int tid) {
    asm volatile("s_waitcnt vmcnt(0) lgkmcnt(0)\n\ts_nop 15\n\ts_nop 15" ::: "memory");
    const int lane = tid & 63, r32 = lane & 31, hi = lane >> 5; const int wid = __builtin_amdgcn_readfirstlane(tid >> 6);
    const unsigned char* QA = (const unsigned char*)(a->ws + WS_QA); const unsigned char* KA = (const unsigned char*)(a->ws + WS_KA); const unsigned char* VT = (const unsigned char*)(a->ws + WS_VA);
    const size_t tok0 = (size_t)b * SEQ;
    const int qw0 = qb * 256 + wid * 32, qpos = qw0 + r32;
    const float slope2 = exp2f(-(float)(h + 1)) * LOG2E;
    const int krow = tid >> 3, kch = tid & 7;
    const int vrow0 = tid >> 2, vch = tid & 3;
    const unsigned koff = (unsigned)(krow * 1024 + kch * 8), voff = (unsigned)(vrow0 * 2048 + vch * 16);
    const unsigned kdst = (unsigned)(krow * AT_KP8 + kch * 8);
    const unsigned vdst = (unsigned)(vrow0 * AT_KP8 + vch * 16);
    const unsigned kfr = (unsigned)(r32 * AT_KP8 + hi * 32);
    const unsigned vfr = (unsigned)(r32 * AT_KP8 + hi * 32);
    const float fq4 = (float)(qpos - 4 * hi);
    bf16x8 kx0, kx1;
    { const unsigned one2 = 0x3f803f80u, z = 0u; const unsigned k0 = f2bf((float)r32), k1 = f2bf((float)(r32 + 32));
      const u32x4 w0 = hi ? (u32x4){z, z, z, z} : (u32x4){one2, 0x3f80u | (k0 << 16), k0, z}, w1 = hi ? (u32x4){z, z, z, z} : (u32x4){one2, 0x3f80u | (k1 << 16), k1, z};
      kx0 = __builtin_bit_cast(bf16x8, w0); kx1 = __builtin_bit_cast(bf16x8, w1); }
    const unsigned s2h = f2bf(slope2); const unsigned s2l = f2bf(slope2 - bflo(s2h));
    LAS unsigned* o1l = (LAS unsigned*)(lds + AT_O1 + wid * 8192) + lane;
    f32x16 o[4];
    float linv_keep = 0.f;
    if (wid >= 4) __builtin_amdgcn_s_setprio(1);
#pragma unroll 1
    for (int p = 0; p < 2; ++p) {
        const unsigned char* Kp = KA + tok0 * 1024 + h * 128 + p * 64;
        const unsigned char* Vp = VT + (size_t)((b * 8 + h) * 128) * 2048;
        const char* const Kpc = (const char*)Kp; const char* const Vpc = (const char*)Vp;
#define AT_LDK(t_) (*(const u32x2*)(Kpc + (size_t)((unsigned)((t_) << 16) + koff)))
#define AT_LDV0(t_) (*(const u32x4*)(Vpc + (size_t)((unsigned)((t_) << 6) + voff)))
        i32x8 qf;
        { const i32x4 q0 = *(const i32x4*)(QA + (tok0 + qpos) * 1024 + h * 128 + p * 64 + hi * 32), q1 = *(const i32x4*)(QA + (tok0 + qpos) * 1024 + h * 128 + p * 64 + hi * 32 + 16);
          qf = __builtin_shufflevector(q0, q1, 0, 1, 2, 3, 4, 5, 6, 7); }
        float m = 0.f, lsum = 0.f;
        float qn2 = 0.f;
#pragma unroll
        for (int j = 0; j < 8; ++j) { const f32x2 x0 = __builtin_amdgcn_cvt_pk_f32_fp8(qf[j], false), x1 = __builtin_amdgcn_cvt_pk_f32_fp8(qf[j], true); qn2 += (x0.x * x0.x + x0.y * x0.y) + (x1.x * x1.x + x1.y * x1.y); }
        qn2 = xhalf_sum(qn2) * (1.0f / (QA8_SCALE * QA8_SCALE));
#pragma unroll
        for (int o_ = 1; o_ < 32; o_ <<= 1) qn2 = fmaxf(qn2, __shfl_xor(qn2, o_));
        qn2 = __uint_as_float((unsigned)__builtin_amdgcn_readfirstlane((int)__float_as_uint(qn2)));
        if (tid < 32) ((LAS unsigned*)(lds + AT_KN))[tid] = 0u;
        __syncthreads();
        const bool can_skip = slope2 * 1793.0f > 48.0f;
#pragma unroll 1
        for (int j0 = 0; can_skip && j0 < SEQ / 64; j0 += 16) { u32x2 kk[16];
#pragma unroll
            for (int j = 0; j < 16; ++j) kk[j] = AT_LDK(j0 + j);
#pragma unroll
            for (int j = 0; j < 16; ++j) { float ss = 0.f;
#pragma unroll
                for (int c = 0; c < 2; ++c) { const f32x2 x0 = __builtin_amdgcn_cvt_pk_f32_fp8((int)kk[j][c], false), x1 = __builtin_amdgcn_cvt_pk_f32_fp8((int)kk[j][c], true); ss += (x0.x * x0.x + x0.y * x0.y) + (x1.x * x1.x + x1.y * x1.y); }
                ss *= QA8_SCALE * QA8_SCALE;
                ss += __shfl_xor(ss, 1); ss += __shfl_xor(ss, 2); ss += __shfl_xor(ss, 4);
                ss = fmaxf(ss, __shfl_xor(ss, 8)); ss = fmaxf(ss, __shfl_xor(ss, 16)); ss = fmaxf(ss, __shfl_xor(ss, 32));
                if (lane == 0) (void)__hip_atomic_fetch_max((LAS unsigned*)(lds + AT_KN) + j0 + j, __float_as_uint(ss), __ATOMIC_RELAXED, __HIP_MEMORY_SCOPE_WORKGROUP); } }
#pragma unroll
        for (int e = 0; e < 4; ++e) o[e] = (f32x16){};
        unsigned keep = 0xFFFFFFFFu; int n = 0, ic = 0, i1 = 1, i2 = 2;
        int kt = attn_tile(0, qb);
        u32x2 kreg = AT_LDK(kt);
        u32x4 vreg0 = AT_LDV0(kt);
        *(LAS u32x2*)(lds + AT_K0 + kdst) = kreg; *(LAS u32x4*)(lds + AT_V0 + vdst) = vreg0;
        { const int k1 = attn_tile(1, qb);
          kreg = AT_LDK(k1);
          vreg0 = AT_LDV0(k1); }
        __syncthreads();
#pragma unroll 1
        for (; ic < SEQ / 64; ++n) {
            const int it = n;
            const int cb = n & 1;
            if (n == 4 && can_skip) {
                const LAS float* red = (const LAS float*)(lds + AT_RED); float A2 = red[0], Mm = red[1];
#pragma unroll
                for (int w = 1; w < 8; ++w) { A2 = fmaxf(A2, red[2 * w]); Mm = fminf(Mm, red[2 * w + 1]); }
                const int i = lane & 31, t = attn_tile(i, qb);
                const int dmin = t * 64 > qb * 256 + 255 ? t * 64 - (qb * 256 + 255) : qb * 256 - (t * 64 + 63);
                const float kn2 = __uint_as_float(((const LAS unsigned*)(lds + AT_KN))[t]);
                const float bound = sqrtf(A2 * kn2) * 1.0001f - Mm - slope2 * (float)dmin;
                const bool kp = !(bound < -36.0f);
                keep = (unsigned)__builtin_amdgcn_readfirstlane((int)(unsigned)(__ballot(kp) & 0xFFFFFFFFull)) | 0x3Fu;
                i1 = 5; { const unsigned r = keep & ~0x3Fu; i2 = r ? __builtin_ctz(r) : 32; }
            }
            const int ktn = (i1 < SEQ / 64) ? attn_tile(i1, qb) : kt;
            if (i1 < SEQ / 64) {
                const int nb = cb ^ 1;
                *(LAS u32x2*)(lds + AT_K0 + nb * AT_KB + kdst) = kreg; *(LAS u32x4*)(lds + AT_V0 + nb * AT_VB + vdst) = vreg0;
                if (i2 < SEQ / 64) { const int k2 = attn_tile(i2, qb);
                    kreg = AT_LDK(k2);
                    vreg0 = AT_LDV0(k2); }
            }
            const LAS unsigned char* Kb = lds + AT_K0 + cb * AT_KB; const LAS unsigned char* Vb = lds + AT_V0 + cb * AT_VB;
            const int cls = (kt * 64 + 63 < qw0) ? 0 : ((kt * 64 > qw0 + 31) ? 1 : 2);
            f32x16 p0, p1;
            i32x8 ka, kb2;
            ka = __builtin_shufflevector(*(const LAS i32x4*)(Kb + kfr), *(const LAS i32x4*)(Kb + kfr + 16), 0, 1, 2, 3, 4, 5, 6, 7);
            kb2 = __builtin_shufflevector(*(const LAS i32x4*)(Kb + kfr + 32 * AT_KP8), *(const LAS i32x4*)(Kb + kfr + 32 * AT_KP8 + 16), 0, 1, 2, 3, 4, 5, 6, 7);
            { const float ts = cls == 0 ? slope2 * ((float)(kt * 64) - fq4 - 4.f * (float)hi) : (cls == 1 ? slope2 * (fq4 + 4.f * (float)hi - (float)(kt * 64)) : 0.f);
              const float S = ts - m; const unsigned sa = f2bf(S); const float r1 = S - bflo(sa); const unsigned sb = f2bf(r1); const unsigned sc = f2bf(r1 - bflo(sb));
              const unsigned sg_ = cls == 1 ? 0x8000u : 0u; const unsigned sh = cls == 2 ? 0u : (s2h ^ sg_), sl = cls == 2 ? 0u : (s2l ^ sg_);
              const u32x4 qw = (u32x4){sa | (sb << 16), sc | (sh << 16), sl, 0u};
              const bf16x8 qx = __builtin_bit_cast(bf16x8, qw);
              asm volatile("v_mfma_f32_32x32x64_f8f6f4 %0, %1, %2, 0" : "=&v"(p0) : "v"(ka), "v"(qf));
              asm volatile("v_mfma_f32_32x32x64_f8f6f4 %0, %1, %2, 0" : "=&v"(p1) : "v"(kb2), "v"(qf));
              asm volatile("s_nop 15\n\ts_nop 7" : "+v"(p0), "+v"(p1));
              p0 = __builtin_amdgcn_mfma_f32_32x32x16_bf16(kx0, qx, p0, 0, 0, 0); p1 = __builtin_amdgcn_mfma_f32_32x32x16_bf16(kx1, qx, p1, 0, 0, 0); }
            i32x8 vt[4];
#pragma unroll
            for (int e = 0; e < 4; ++e) vt[e] = __builtin_shufflevector(*(const LAS i32x4*)(Vb + vfr + e * 32 * AT_KP8), *(const LAS i32x4*)(Vb + vfr + e * 32 * AT_KP8 + 16), 0, 1, 2, 3, 4, 5, 6, 7);
            __builtin_amdgcn_sched_barrier(0);
            if (cls == 2) {
                const float fqh = fq4 - (float)(kt * 64);
#pragma unroll
                for (int r = 0; r < 16; ++r) { p0[r] = p0[r] - slope2 * fabsf(fqh - CROWF(r)); p1[r] = p1[r] - slope2 * fabsf(fqh - 32.f - CROWF(r)); }
            }
            float mx = fmaxf(fmaxf(p0[0], p0[1]), fmaxf(p1[0], p1[1]));
#pragma unroll
            for (int r = 2; r < 16; r += 2) { mx = fmaxf(fmaxf(mx, p0[r]), p0[r + 1]); mx = fmaxf(fmaxf(mx, p1[r]), p1[r + 1]); }
            mx = xhalf_max(mx);
            if (it == 0 || !__all(mx <= 8.0f)) {
                const float dl = it == 0 ? mx - 4.0f : fmaxf(mx - 4.0f, 0.f), alpha = it == 0 ? 1.0f : __builtin_amdgcn_exp2f(-dl); m += dl; lsum *= alpha;
                asm volatile("s_nop 15\n\ts_nop 7" ::: "memory");
#pragma unroll
                for (int e = 0; e < 4; ++e)
#pragma unroll
                    for (int r = 0; r < 16; ++r) o[e][r] *= alpha;
#pragma unroll
                for (int r = 0; r < 16; ++r) { p0[r] -= dl; p1[r] -= dl; }
            }
            float rs = 0.f;
#pragma unroll
            for (int r = 0; r < 16; ++r) { p0[r] = __builtin_amdgcn_exp2f(p0[r]); p1[r] = __builtin_amdgcn_exp2f(p1[r]); rs += p0[r] + p1[r]; }
            lsum += rs;
            i32x8 pb;
#pragma unroll
            for (int i = 0; i < 4; ++i) { int w0 = 0, w1 = 0;
                w0 = __builtin_amdgcn_cvt_pk_fp8_f32(p0[4 * i + 0], p0[4 * i + 1], w0, false); w0 = __builtin_amdgcn_cvt_pk_fp8_f32(p0[4 * i + 2], p0[4 * i + 3], w0, true);
                w1 = __builtin_amdgcn_cvt_pk_fp8_f32(p1[4 * i + 0], p1[4 * i + 1], w1, false); w1 = __builtin_amdgcn_cvt_pk_fp8_f32(p1[4 * i + 2], p1[4 * i + 3], w1, true);
                pb[i] = w0; pb[4 + i] = w1; }
            asm volatile("s_nop 3" : "+v"(pb));
#pragma unroll
            for (int e = 0; e < 4; ++e) asm volatile("v_mfma_f32_32x32x64_f8f6f4 %0, %1, %2, %0" : "+v"(o[e]) : "v"(vt[e]), "v"(pb));
            if (n == 3) {
                float mm = m;
#pragma unroll
                for (int o_ = 1; o_ < 32; o_ <<= 1) mm = fminf(mm, __shfl_xor(mm, o_));
                if (lane == 0) { LAS float* red = (LAS float*)(lds + AT_RED); red[2 * wid] = qn2; red[2 * wid + 1] = mm; }
            }
            kt = ktn; ic = i1; i1 = i2;
            { const unsigned r = (i2 < 31) ? (keep & (0xFFFFFFFEu << i2)) : 0u; i2 = r ? __builtin_ctz(r) : 32; }
            __syncthreads();
        }
        asm volatile("s_nop 15\n\ts_nop 7" ::: "memory");
        const float linv = (1.0f / V8_SCALE) / xhalf_sum(lsum);
        if (p == 0) {
#pragma unroll
            for (int e = 0; e < 4; ++e)
#pragma unroll
                for (int r = 0; r < 16; r += 2) o1l[(e * 8 + (r >> 1)) * 64] = cvt_pk_bf16(o[e][r] * linv, o[e][r + 1] * linv);
        } else linv_keep = linv;
    }
#undef AT_LDK
#undef AT_LDV0
#undef AT_LDV1
    __builtin_amdgcn_s_setprio(0);
    float ss = 0.f;
#pragma unroll
    for (int e = 0; e < 4; ++e)
#pragma unroll
        for (int r = 0; r < 16; r += 2) { const unsigned w = o1l[(e * 8 + (r >> 1)) * 64];
            o[e][r] = bflo(w) - lam * (o[e][r] * linv_keep); o[e][r + 1] = bfhi(w) - lam * (o[e][r + 1] * linv_keep);
            ss += o[e][r] * o[e][r] + o[e][r + 1] * o[e][r + 1]; }
    ss = xhalf_sum(ss);
    const float lam_init = 0.8f - 0.6f * expf(-0.3f * (float)l);
    const float rn = (1.0f / sqrtf(ss * (1.f / 128.f) + LN_EPS)) * (1.0f - lam_init);
    const float* sg = a->in[I_SUBG] + l * 128;
    unsigned char* orow = (unsigned char*)(a->ws + WS_OA8) + (tok0 + qpos) * 1024 + h * 128;
    const float rn8 = rn * OA8_SCALE;
#pragma unroll
    for (int e = 0; e < 4; ++e)
#pragma unroll
        for (int r4 = 0; r4 < 4; ++r4) { const int ecol = 32 * e + 8 * r4 + 4 * hi; const f32x4 g = *(const f32x4*)(sg + ecol);
            int pk = 0; pk = __builtin_amdgcn_cvt_pk_fp8_f32(o[e][4 * r4 + 0] * rn8 * g.x, o[e][4 * r4 + 1] * rn8 * g.y, pk, false); pk = __builtin_amdgcn_cvt_pk_fp8_f32(o[e][4 * r4 + 2] * rn8 * g.z, o[e][4 * r4 + 3] * rn8 * g.w, pk, true);
            *(int*)(orow + ecol) = pk; }
}

constexpr int NA_NINF_OFF = TAB_OFF + 3072;
constexpr int NA_RPB_OFF = 101312, NA_V_OFF = 0, NA_SCR_OFF = 32768;
__device__ __forceinline__ void na_wave_unit(KArgs a, int uidx, LAS unsigned char* lds, int wave, int lane) {
    asm volatile("s_waitcnt vmcnt(0) lgkmcnt(0)\n\ts_nop 15\n\ts_nop 15" ::: "memory");
    const int r32 = lane & 31, hi = lane >> 5;
    const int qbh = uidx & 1, head = (uidx >> 1) & 15, r = (uidx >> 5) & 31, b = uidx >> 10;
    const bf16_t* QN = (const bf16_t*)(a->ws + WS_QN); const bf16_t* KN = (const bf16_t*)(a->ws + WS_KN); const bf16_t* VN = (const bf16_t*)(a->ws + WS_VN);
    LAS unsigned char* Vw = lds + NA_V_OFF + wave * 4096;
    LAS unsigned char* Kw = lds + NA_SCR_OFF + wave * 8448;
    const int c = 32 * qbh + r32; const size_t tq = (size_t)b * SEQ + r * 64 + c;
    const int rs = min(max(r - 4, 0), 24), cs = min(max(c - 8, 0), 48);
    bf16x8 qf[2];
#pragma unroll
    for (int d0 = 0; d0 < 2; ++d0) qf[d0] = *(const bf16x8*)(QN + tq * 512 + head * 32 + d0 * 16 + hi * 8);
    const unsigned vfr = (unsigned)(((lane >> 4) & 1) * 32 + (lane & 3) * 8 + (4 * hi + ((lane & 15) >> 2)) * 64);
    float m = -1e30f, lsum = 0.f; f32x16 o = (f32x16){};
    const int fb = 32 * qbh, hb = qbh ? 24 : 32;
    unsigned ad0[16], ad1[4];
    { const unsigned base = (unsigned)(NA_RPB_OFF + (head * 465 + (rs - r + 7) * 31 + (15 - c)) * 4);
#pragma unroll
      for (int rr = 0; rr < 16; ++rr) { const int kc0 = fb + (rr & 3) + 8 * (rr >> 2) + 4 * hi;
          const bool v0 = (kc0 >= cs) && (kc0 < cs + 16);
          ad0[rr] = v0 ? base + (unsigned)(kc0 * 4) : (unsigned)NA_NINF_OFF; }
#pragma unroll
      for (int rr = 0; rr < 4; ++rr) { const int kc1 = hb + rr + 4 * hi;
          const bool v1 = (kc1 >= cs) && (kc1 < cs + 16);
          ad1[rr] = v1 ? base + (unsigned)(kc1 * 4) : (unsigned)NA_NINF_OFF; } }
    u32x4 kr4[3]; u32x4 vr[3];
    const unsigned char* KNh = (const unsigned char*)KN + ((size_t)(b * 16 + head) * 2048 + 16 * qbh) * 64 + lane * 16;
    const unsigned char* VNh = (const unsigned char*)VN + ((size_t)(b * 16 + head) * 2048 + 16 * qbh) * 64 + lane * 16;
    const int kst = 16 * qbh + (lane >> 2);
#pragma unroll
    for (int j = 0; j < 3; ++j) kr4[j] = *(const u32x4*)(KNh + (size_t)(rs * 4096 + j * 1024));
#pragma unroll
    for (int j = 0; j < 3; ++j) vr[j] = *(const u32x4*)(VNh + (size_t)(rs * 4096 + j * 1024));
#pragma unroll 1
    for (int kr = 0; kr < 8; ++kr) {
        const int R = rs + kr;
#pragma unroll
        for (int j = 0; j < 3; ++j) *(LAS u32x4*)(Vw + (kst + 16 * j) * 64 + (lane & 3) * 16) = vr[j];
#pragma unroll
        for (int j = 0; j < 3; ++j) *(LAS u32x4*)(Kw + (kst + 16 * j) * 80 + (lane & 3) * 16) = kr4[j];
        if (kr + 1 < 8) {
#pragma unroll
            for (int j = 0; j < 3; ++j) { kr4[j] = *(const u32x4*)(KNh + (size_t)((R + 1) * 4096 + j * 1024));
                vr[j] = *(const u32x4*)(VNh + (size_t)((R + 1) * 4096 + j * 1024)); }
        }
        bf16x8 kc[4];
#pragma unroll
        for (int d0 = 0; d0 < 2; ++d0) { kc[2 * d0] = *(const LAS bf16x8*)(Kw + (fb + r32) * 80 + d0 * 32 + hi * 16); kc[2 * d0 + 1] = *(const LAS bf16x8*)(Kw + (hb + r32) * 80 + d0 * 32 + hi * 16); }
        f32x16 p0, p1 = (f32x16){};
#pragma unroll
        for (int rr = 0; rr < 16; ++rr) { p0[rr] = *(const LAS float*)(lds + ad0[rr]); ad0[rr] += 124u; }
#pragma unroll
        for (int rr = 0; rr < 4; ++rr) { p1[rr] = *(const LAS float*)(lds + ad1[rr]); ad1[rr] += 124u; }
        asm volatile("s_waitcnt lgkmcnt(0)" ::: "memory");
#pragma unroll
        for (int d0 = 0; d0 < 2; ++d0) {
            p0 = __builtin_amdgcn_mfma_f32_32x32x16_bf16(kc[2 * d0], qf[d0], p0, 0, 0, 0);
            p1 = __builtin_amdgcn_mfma_f32_32x32x16_bf16(kc[2 * d0 + 1], qf[d0], p1, 0, 0, 0);
        }
        float mx = fmaxf(p0[0], p1[0]);
#pragma unroll
        for (int rr = 1; rr < 16; ++rr) mx = rr < 4 ? fmaxf(fmaxf(mx, p0[rr]), p1[rr]) : fmaxf(mx, p0[rr]);
        mx = xhalf_max(mx);
        const float mn = fmaxf(fmaxf(m, mx), -1e30f), alpha = __builtin_amdgcn_exp2f(m - mn); m = mn;
        float rsum = 0.f;
#pragma unroll
        for (int rr = 0; rr < 16; ++rr) { p0[rr] = __builtin_amdgcn_exp2f(p0[rr] - mn); rsum += p0[rr]; }
#pragma unroll
        for (int rr = 0; rr < 4; ++rr) { p1[rr] = __builtin_amdgcn_exp2f(p1[rr] - mn); rsum += p1[rr]; }
        lsum = lsum * alpha + rsum;
#pragma unroll
        for (int rr = 0; rr < 16; ++rr) o[rr] *= alpha;
        bf16x8 pb[3];
#pragma unroll
        for (int s = 0; s < 2; ++s) { u32x4 w; w.x = cvt_pk_bf16(p0[8 * s + 0], p0[8 * s + 1]); w.y = cvt_pk_bf16(p0[8 * s + 2], p0[8 * s + 3]); w.z = cvt_pk_bf16(p0[8 * s + 4], p0[8 * s + 5]); w.w = cvt_pk_bf16(p0[8 * s + 6], p0[8 * s + 7]);
            pb[s] = __builtin_bit_cast(bf16x8, w); }
        { u32x4 w; w.x = cvt_pk_bf16(p1[0], p1[1]); w.y = cvt_pk_bf16(p1[2], p1[3]); w.z = 0u; w.w = 0u; pb[2] = __builtin_bit_cast(bf16x8, w); }
        s16x4 lo[3], hi4[3];
#pragma unroll
        for (int s = 0; s < 2; ++s) { lo[s] = ds_tr(Vw + vfr + (fb + 16 * s) * 64); hi4[s] = ds_tr(Vw + vfr + (fb + 16 * s) * 64 + 512); }
        lo[2] = ds_tr(Vw + vfr + hb * 64); hi4[2] = ds_tr(Vw + vfr + hb * 64 + 512);
        asm volatile("s_waitcnt lgkmcnt(0)" ::: "memory");
#pragma unroll
        for (int s = 0; s < 3; ++s) o = __builtin_amdgcn_mfma_f32_32x32x16_bf16(cat8(lo[s], hi4[s]), pb[s], o, 0, 0, 0);
    }
    const float linv = OB8_SCALE / xhalf_sum(lsum);
    unsigned char* orow = (unsigned char*)(a->ws + WS_OB8) + (size_t)tq * 512 + head * 32;
#pragma unroll
    for (int r4 = 0; r4 < 4; ++r4) { const int ecol = 8 * r4 + 4 * hi;
        int pk = 0; pk = __builtin_amdgcn_cvt_pk_fp8_f32(o[4 * r4 + 0] * linv, o[4 * r4 + 1] * linv, pk, false); pk = __builtin_amdgcn_cvt_pk_fp8_f32(o[4 * r4 + 2] * linv, o[4 * r4 + 3] * linv, pk, true);
        *(int*)(orow + ecol) = pk; }
}

__device__ __forceinline__ void build_table(const unsigned* cnt, LAS unsigned char* lds) {
    LAS int* tab = (LAS int*)(lds + TAB_OFF); LAS int* tmp = (LAS int*)(lds + TAB_OFF + 2048);
    int tid_ = threadIdx.x; asm volatile("" : "+v"(tid_));
    const int tid = tid_;
    __syncthreads();
    if (tid < 256) tmp[tid] = (int)((__hip_atomic_load(cnt + tid, __ATOMIC_RELAXED, __HIP_MEMORY_SCOPE_AGENT) + 255u) >> 8);
    __syncthreads();
    if (tid < 256) { int s = 0; for (int j = 0; j < tid; ++j) s += tmp[j]; tab[tid] = s; if (tid == 255) { tab[256] = s + tmp[255]; tab[257] = s + tmp[255] + T / 256; } }
    __syncthreads();
}

__device__ __forceinline__ float route_sig(float x) { return 1.0f / (1.0f + expf(-x)); }
__device__ __forceinline__ void route_phase(KArgs a, int l, LAS unsigned char* lds, int G) {
    int tid_ = threadIdx.x; asm volatile("" : "+v"(tid_));
    const int tid = tid_;
    const float* LT = (const float*)(a->ws + WS_LOGIT); const float* rbias = a->in[I_RB] + l * 256;
    int* reidx = (int*)(a->ws + WS_REIDX); int* rpos = (int*)(a->ws + WS_RPOS); float* rw = (float*)(a->ws + WS_RW);
    unsigned* cnt = (unsigned*)(a->ws + WS_CTL) + CW_CNT + l * 256;
    LAS int* hist = (LAS int*)lds; LAS int* base = hist + 256; LAS int* le = base + 256; LAS int* lp = le + 2048; LAS float* lb = (LAS float*)(lp + 2048); LAS float* gsl = lb + 256;
    for (int panel = blockIdx.x; panel < T / 256; panel += G) {
        __syncthreads();
        if (tid < 256) { hist[tid] = 0; lb[tid] = rbias[tid]; }
        __syncthreads();
        { const int tok = tid & 255, half = __builtin_amdgcn_readfirstlane(tid >> 8); const float* lt = LT + (size_t)panel * 256 + tok;
#pragma unroll
          for (int g4 = 0; g4 < 4; ++g4) { const int g = 4 * half + g4; float m1 = -INFINITY, m2 = -INFINITY;
              float x[32];
#pragma unroll
              for (int j = 0; j < 32; ++j) x[j] = lt[(size_t)(g * 32 + j) * T];
#pragma unroll
              for (int j = 0; j < 32; ++j) { const float v = route_sig(x[j]) + lb[g * 32 + j]; const float t = fminf(m1, v); m1 = fmaxf(m1, v); m2 = fmaxf(m2, t); }
              gsl[tok * 9 + g] = m1 + m2; } }
        __syncthreads();
        if (tid < 256) {
            const size_t row = (size_t)panel * 256 + tid; const float* lt = LT + row;
            float gs[8];
#pragma unroll
            for (int g = 0; g < 8; ++g) gs[g] = gsl[tid * 9 + g];
            unsigned gmask = 0;
#pragma unroll
            for (int g = 0; g < 8; ++g) { int rank = 0;
#pragma unroll
                for (int j = 0; j < 8; ++j) rank += (gs[j] > gs[g] || (gs[j] == gs[g] && j < g)) ? 1 : 0;
                if (rank < 4) gmask |= 1u << g; }
            float tv[8]; int te[8];
#pragma unroll
            for (int k = 0; k < 8; ++k) { tv[k] = -INFINITY; te[k] = 0; }
#pragma unroll 1
            for (int g = 0; g < 8; ++g) { if (!((gmask >> g) & 1u)) continue;
                float x[32];
#pragma unroll
                for (int j = 0; j < 32; ++j) x[j] = lt[(size_t)(g * 32 + j) * T];
#pragma unroll
                for (int j = 0; j < 32; ++j) { const int e = g * 32 + j; float v = route_sig(x[j]) + lb[e];
                    if (v > tv[7]) { int ev = e; bool ins = false;
#pragma unroll
                        for (int k = 0; k < 8; ++k) { ins = ins || (v > tv[k]); const bool sw = ins;   const float tvv = tv[k]; const int tee = te[k]; tv[k] = sw ? v : tvv; te[k] = sw ? ev : tee; v = sw ? tvv : v; ev = sw ? tee : ev; } } } }
            float gv[8], gsum = 0.f;
#pragma unroll
            for (int k = 0; k < 8; ++k) { gv[k] = tv[k] - lb[te[k]]; gsum += gv[k]; }
            const float sc = ROUTE_SCALE / gsum;
#pragma unroll
            for (int k = 0; k < 8; ++k) { const int pos = atomicAdd((int*)&hist[te[k]], 1); le[tid * 8 + k] = te[k]; lp[tid * 8 + k] = pos; rw[row * 8 + k] = gv[k] * sc; }
        }
        __syncthreads();
        if (tid < 256) { const int c = hist[tid]; base[tid] = c ? (int)__hip_atomic_fetch_add(cnt + tid, (unsigned)c, __ATOMIC_RELAXED, __HIP_MEMORY_SCOPE_AGENT) : 0; }
        __syncthreads();
        for (int i = tid; i < 2048; i += 512) { const int e = le[i]; const size_t gi = (size_t)panel * 2048 + i; reidx[gi] = e; rpos[gi] = base[e] + lp[i]; }
    }
}

__device__ __forceinline__ void slot_phase(KArgs a, int l, LAS unsigned char* lds, int G) {
    int tid_ = threadIdx.x; asm volatile("" : "+v"(tid_));
    const int tid = tid_;
    const LAS int* tab = (const LAS int*)(lds + TAB_OFF);
    const int* reidx = (const int*)(a->ws + WS_REIDX); const int* rpos = (const int*)(a->ws + WS_RPOS); const float* rw = (const float*)(a->ws + WS_RW);
    int* stok = (int*)(a->ws + WS_STOK); u32x2* sinf = (u32x2*)(a->ws + WS_SDST);
    const unsigned* cnt = (const unsigned*)(a->ws + WS_CTL) + CW_CNT + l * 256;
    for (size_t i = (size_t)blockIdx.x * 512 + tid; i < (size_t)T * 8; i += (size_t)G * 512) {
        const int e = reidx[i]; const int slot = tab[e] * 256 + rpos[i];
        stok[slot] = (int)(i >> 3); sinf[slot] = (u32x2){(unsigned)i, __builtin_bit_cast(unsigned, rw[i])};
    }
    for (int e = blockIdx.x; e < 256; e += G) {
        const int c = (int)__hip_atomic_load(cnt + e, __ATOMIC_RELAXED, __HIP_MEMORY_SCOPE_AGENT); const int pend = ((c + 255) >> 8) << 8;
        for (int s = c + tid; s < pend; s += 512) { const int slot = tab[e] * 256 + s; stok[slot] = 0; sinf[slot] = (u32x2){0xffffffffu, 0u}; }
    }
}

constexpr int NPHASE = 1 + 11 * DEPTH;
#ifndef LBW
#define LBW 2
#endif
#ifndef PHMASK
#define PHMASK 0xFFF
#endif
#define EN(j) (((PHMASK) >> (j)) & 1)
__global__ void __launch_bounds__(NWAVES * 64, LBW) mega_fwd(Args a_kernarg) {
    extern __shared__ __attribute__((aligned(16))) unsigned char lds_raw[];
    LAS unsigned char* lds = (LAS unsigned char*)lds_raw;
    const int G = gridDim.x;
#define PH_IDS KArgs a = kargs(); int tid_ = threadIdx.x; asm volatile("" : "+v"(tid_)); const int tid = tid_, lane = tid & 63; const int wave = __builtin_amdgcn_readfirstlane(tid >> 6); \
    const int gw = blockIdx.x * NWAVES + wave, ngw = G * NWAVES; (void)lane; (void)gw; (void)ngw; (void)a;
    for (int u = threadIdx.x; u < 256; u += NWAVES * 64) ((LAS unsigned*)(lds + MISC_OFF))[u] = 0u;
    __syncthreads();
    int lo, hi;
    { KArgs a0 = kargs(); lo = a0->ph_lo; hi = a0->ph_hi; }
#if MK_ONE_LAUNCH
    XcdBarrier bar;
    { KArgs a0 = kargs(); bar = xcd_barrier_post((unsigned*)(a0->ws + WS_CTL) + CW_BAR, (volatile LAS unsigned*)(lds + MISC_OFF)); }
#define GRID_BAR() xcd_barrier(bar)
#else
#define GRID_BAR() do {} while (0)
#endif
#define IN(k) (lo <= (k) && (k) < hi)
#define SEAM(k) do { if (IN(k) && IN((k) + 1)) GRID_BAR(); } while (0)

    if (EN(11) && IN(0)) {
        PH_IDS
        float* H = a->out; bf16_t* HB = (bf16_t*)(a->ws + WS_HB);
        convert_small(a, lds, gw, ngw, lane, wave);
        for (int m = gw; m < T; m += 2 * ngw) { f32x4 v[4], w[4]; const int m2 = m + ngw; const bool two = m2 < T;
#pragma unroll
            for (int j = 0; j < 4; ++j) v[j] = *(const f32x4*)(a->in[I_X] + (size_t)m * 1024 + 4 * lane + 256 * j);
            if (two) {
#pragma unroll
                for (int j = 0; j < 4; ++j) w[j] = *(const f32x4*)(a->in[I_X] + (size_t)m2 * 1024 + 4 * lane + 256 * j); }
            ln_store(v, a->in[I_EG], a->in[I_EB], nullptr, HB + (size_t)m * 1024, (unsigned char*)(a->ws + WS_HB8) + (size_t)m * 1024, lane);
            if (two) ln_store(w, a->in[I_EG], a->in[I_EB], nullptr, HB + (size_t)m2 * 1024, (unsigned char*)(a->ws + WS_HB8) + (size_t)m2 * 1024, lane); }
    }
    SEAM(0);
#pragma unroll 1
    for (int l = 0; l < DEPTH; ++l) {
        const int pb = 1 + 11 * l;
        if (EN(0) && IN(pb + 0)) {
            KArgs a = kargs();
            { InProjOrder S; S.init((const bf16_t*)(a->ws + WS_HB8), (const bf16_t*)(a->ws + WS_WIN + (size_t)l * NCOL * 1024), T, NCOL - 1024, 512, G, (int)blockIdx.x);
              EpiInProj E{a->ws, a->in[I_BG] + l * 2048};
              pg8::gemm_phase<EpiInProj, InProjOrder, true>(lds, lds + XOFF_LDS, 512, S, E); }
            { KArgs a2 = kargs();
              pg8::DenseOrder S; S.init((const bf16_t*)(a2->ws + WS_WIN + ((size_t)l * NCOL + 2048) * 1024), (const bf16_t*)(a2->ws + WS_HB8), 1024, T, 512, G, (int)blockIdx.x);
              EpiVT E{(unsigned char*)(a2->ws + WS_VA)};
              pg8::gemm_phase<EpiVT, pg8::DenseOrder, true>(lds, lds + XOFF_LDS, 512, S, E); }
        }
        SEAM(pb + 0);
        if (EN(1) && IN(pb + 1)) {
            PH_IDS
            float lam;
            { const float q1 = a->in[I_LQ1][l * 64 + lane] * a->in[I_LK1][l * 64 + lane], q2 = a->in[I_LQ2][l * 64 + lane] * a->in[I_LK2][l * 64 + lane];
              lam = expf(wave_sum(q1)) - expf(wave_sum(q2)) + (0.8f - 0.6f * expf(-0.3f * (float)l));
              lam = __uint_as_float((unsigned)__builtin_amdgcn_readfirstlane((int)__float_as_uint(lam))); }
            { const float* rp = a->in[I_RPB] + (size_t)l * 16 * 465; LAS float* rl = (LAS float*)(lds + NA_RPB_OFF);
              for (int i = tid; i < 16 * 465; i += NWAVES * 64) rl[i] = rp[i] * LOG2E;
              if (tid < 256) ((LAS float*)(lds + NA_NINF_OFF))[tid] = -INFINITY; }
            LAS float* scr = (LAS float*)(lds + NA_SCR_OFF + wave * 8448);
            int k = 0;
            constexpr int NA_UNITS = BATCH * 32 * 16 * 2;
            for (int i = 0;; ++i) { const int L = i * G + (int)blockIdx.x; const bool hasu = L < BATCH * 8 * 8;
                if (hasu) { const int c = L & 255;
                    diffattn_unit(a, l, (c & 7) + 8 * (c >> 6), L >> 8, (c >> 3) & 7, lam, lds, tid);
                    __syncthreads(); }
                for (int j = 0; hasu ? j < 2 : true; ++j) {
                    const int u = gw + k * ngw, it = gw + 3 * k * ngw; if (u >= NA_UNITS && it >= N_EXP_ITEMS) break;
                    ++k;
                    KArgs a2 = kargs(); int lane2 = lane; asm volatile("" : "+v"(lane2));
                    if (u < NA_UNITS) na_wave_unit(a2, u, lds, wave, lane2);
                    convert_expert_items3(a2, l, it, it + ngw, it + 2 * ngw, scr, lane2); }
                if (!hasu) break;
                __syncthreads();
            }
        }
        SEAM(pb + 1);
        if (EN(2) && IN(pb + 2)) {
            { KArgs a = kargs();
              pg8::DenseOrder S; S.init((const bf16_t*)(a->ws + WS_OA8), (const bf16_t*)(a->ws + WS_WPA + (size_t)l * 1024 * 1024), T, 1024, 512, G, (int)blockIdx.x);
              EpiProj<false> E{(bf16_t*)(a->ws + WS_U), (const unsigned char*)(a->ws + WS_GA), nullptr, W8_INV / (OA8_SCALE * G8_SCALE)};
              pg8::gemm_phase<EpiProj<false>, pg8::DenseOrder, true>(lds, lds + XOFF_LDS, 512, S, E); }
            { KArgs a = kargs();
              pg8::DenseOrder S; S.init((const bf16_t*)(a->ws + WS_OB8), (const bf16_t*)(a->ws + WS_WPB + (size_t)l * 1024 * 512), T, 1024, 256, G, (int)blockIdx.x);
              EpiProj<true> E{(bf16_t*)(a->ws + WS_U), (const unsigned char*)(a->ws + WS_GB), (unsigned char*)(a->ws + WS_U8), W8_INV / (OB8_SCALE * G8_SCALE)};
              pg8::gemm_phase<EpiProj<true>, pg8::DenseOrder, true>(lds, lds + XOFF_LDS, 256, S, E); }
        }
        SEAM(pb + 2);
        if (EN(3) && IN(pb + 3)) {
            KArgs a = kargs();
            pg8::DenseOrder S; S.init((const bf16_t*)(a->ws + WS_U8), (const bf16_t*)(a->ws + WS_WOUT + (size_t)l * 1024 * 1024), T, 1024, 512, G, (int)blockIdx.x);
            EpiFp8Plain E{(unsigned char*)(a->ws + WS_MIX), Y_SCALE * W8_INV / U8_SCALE};
            pg8::gemm_phase<EpiFp8Plain, pg8::DenseOrder, true>(lds, lds + XOFF_LDS, 512, S, E);
        }
        SEAM(pb + 3);
        if (EN(4) && IN(pb + 4)) {
            PH_IDS
            float* H = a->out; bf16_t* HB = (bf16_t*)(a->ws + WS_HB);
            for (int m = gw; m < T; m += 2 * ngw) { f32x4 v[4], w[4]; const int m2 = m + ngw < T ? m + ngw : m;
#pragma unroll
                for (int j = 0; j < 4; ++j) v[j] = ldbf4(HB + (size_t)m * 1024 + 4 * lane + 256 * j) * ALPHA + ldfp8x4((const unsigned char*)(a->ws + WS_MIX) + (size_t)m * 1024 + 4 * lane + 256 * j);
#pragma unroll
                for (int j = 0; j < 4; ++j) w[j] = ldbf4(HB + (size_t)m2 * 1024 + 4 * lane + 256 * j) * ALPHA + ldfp8x4((const unsigned char*)(a->ws + WS_MIX) + (size_t)m2 * 1024 + 4 * lane + 256 * j);
                ln_store(v, a->in[I_L1G] + l * 1024, a->in[I_L1B] + l * 1024, nullptr, HB + (size_t)m * 1024, (unsigned char*)(a->ws + WS_HB8) + (size_t)m * 1024, lane);
                ln_store(w, a->in[I_L1G] + l * 1024, a->in[I_L1B] + l * 1024, nullptr, HB + (size_t)m2 * 1024, (unsigned char*)(a->ws + WS_HB8) + (size_t)m2 * 1024, lane); }
        }
        SEAM(pb + 4);
        if (EN(5) && IN(pb + 5)) {
            KArgs a = kargs();
            pg8::DenseOrder S; S.init((const bf16_t*)(a->ws + WS_HB), (const bf16_t*)(a->ws + WS_WR) + (size_t)l * 256 * 1024, T, 256, 1024, G, (int)blockIdx.x);
            EpiF32T E{(float*)(a->ws + WS_LOGIT), T};
            pg8::gemm_phase(lds, lds + XOFF_LDS, 1024, S, E);
        }
        SEAM(pb + 5);
        if (EN(6) && IN(pb + 6)) { KArgs a = kargs(); route_phase(a, l, lds, G); }
        SEAM(pb + 6);
        if (EN(7) && IN(pb + 7)) { KArgs a = kargs(); build_table((unsigned*)(a->ws + WS_CTL) + CW_CNT + l * 256, lds); slot_phase(a, l, lds, G); }
        SEAM(pb + 7);
        if (EN(8) && IN(pb + 8)) {
            KArgs a = kargs();
            if (!IN(pb + 7)) build_table((unsigned*)(a->ws + WS_CTL) + CW_CNT + l * 256, lds);
            const LAS int* tab = (const LAS int*)(lds + TAB_OFF);
            ExpertOrderGU S{tab, (const bf16_t*)(a->ws + WS_HB8), (const bf16_t*)(a->ws + WS_EGU), (const int*)(a->ws + WS_STOK), G, (int)blockIdx.x, tab[257] * 2};
            EpiSwiglu E{(unsigned char*)(a->ws + WS_HMID)};
            pg8::gemm_phase<EpiSwiglu, ExpertOrderGU, true>(lds, lds + XOFF_LDS, 512, S, E);
        }
        SEAM(pb + 8);
        if (EN(9) && IN(pb + 9)) {
#ifndef NO9A
            { KArgs a = kargs();
              if (!IN(pb + 8)) build_table((unsigned*)(a->ws + WS_CTL) + CW_CNT + l * 256, lds);
              const LAS int* tab = (const LAS int*)(lds + TAB_OFF);
              ExpertOrderDown S{tab, (const bf16_t*)(a->ws + WS_HMID), (const bf16_t*)(a->ws + WS_ED), G, (int)blockIdx.x, tab[256] * 4};
              EpiDown E{(unsigned char*)(a->ws + WS_Y), (const u32x2*)(a->ws + WS_SDST)};
              pg8::gemm_phase<EpiDown, ExpertOrderDown, true>(lds, lds + XOFF_LDS, 128, S, E); }
#endif
#ifndef NO9B
            { KArgs a = kargs();
              const LAS int* tab = (const LAS int*)(lds + TAB_OFF);
              pg8::DenseOrder S; S.init((const bf16_t*)(a->ws + WS_HMID + (size_t)tab[256] * 256 * 256), (const bf16_t*)(a->ws + WS_ED + (size_t)256 * 1024 * 256), T, 1024, 128, G, (int)blockIdx.x);
              EpiFp8Plain E{(unsigned char*)(a->ws + WS_YSH), Y_SCALE * W8_INV / H8_SCALE};
              pg8::gemm_phase<EpiFp8Plain, pg8::DenseOrder, true>(lds, lds + XOFF_LDS, 128, S, E); }
#endif
        }
        SEAM(pb + 9);
        if (EN(10) && IN(pb + 10)) {
            PH_IDS
            float* H = a->out; bf16_t* HB = (bf16_t*)(a->ws + WS_HB);
            const unsigned char* Y = (const unsigned char*)(a->ws + WS_Y);
            for (int m = gw; m < T; m += 2 * ngw) { const int m2 = m + ngw < T ? m + ngw : m;
                int ya[32], yb[32]; u32x2 ha[4], hb[4]; int sa[4], sb[4];
#pragma unroll
                for (int j = 0; j < 4; ++j) { ha[j] = *(const u32x2*)(HB + (size_t)m * 1024 + 4 * lane + 256 * j); sa[j] = *(const int*)((const unsigned char*)(a->ws + WS_YSH) + (size_t)m * 1024 + 4 * lane + 256 * j); }
#pragma unroll
                for (int k = 0; k < 8; ++k)
#pragma unroll
                    for (int j = 0; j < 4; ++j) ya[4 * k + j] = __builtin_nontemporal_load((const int*)(Y + ((size_t)m * 8 + k) * 1024 + 4 * lane + 256 * j));
#pragma unroll
                for (int j = 0; j < 4; ++j) { hb[j] = *(const u32x2*)(HB + (size_t)m2 * 1024 + 4 * lane + 256 * j); sb[j] = *(const int*)((const unsigned char*)(a->ws + WS_YSH) + (size_t)m2 * 1024 + 4 * lane + 256 * j); }
#pragma unroll
                for (int k = 0; k < 8; ++k)
#pragma unroll
                    for (int j = 0; j < 4; ++j) yb[4 * k + j] = __builtin_nontemporal_load((const int*)(Y + ((size_t)m2 * 8 + k) * 1024 + 4 * lane + 256 * j));
#pragma unroll
                for (int r = 0; r < 2; ++r) { const int mm = r ? m2 : m; f32x4 v[4];
#pragma unroll
                    for (int j = 0; j < 4; ++j) { const u32x2 h2 = r ? hb[j] : ha[j]; const int s8 = r ? sb[j] : sa[j];
                        const f32x2 slo = __builtin_amdgcn_cvt_pk_f32_fp8(s8, false), shi = __builtin_amdgcn_cvt_pk_f32_fp8(s8, true);
                        f32x4 ys = (f32x4){0.f, 0.f, 0.f, 0.f};
#pragma unroll
                        for (int k = 0; k < 8; ++k) { const int y = r ? yb[4 * k + j] : ya[4 * k + j];
                            const f32x2 lo = __builtin_amdgcn_cvt_pk_f32_fp8(y, false), hi2 = __builtin_amdgcn_cvt_pk_f32_fp8(y, true);
                            ys.x += lo.x; ys.y += lo.y; ys.z += hi2.x; ys.w += hi2.y; }
                        v[j] = (f32x4){bflo(h2.x), bfhi(h2.x), bflo(h2.y), bfhi(h2.y)} * ALPHA + (f32x4){slo.x, slo.y, shi.x, shi.y} * (1.0f / 32.0f) + ys * (1.0f / Y_SCALE); }
                    ln_store(v, a->in[I_L2G] + l * 1024, a->in[I_L2B] + l * 1024, (l + 1 < DEPTH) ? nullptr : H + (size_t)mm * 1024, (l + 1 < DEPTH) ? HB + (size_t)mm * 1024 : nullptr, (l + 1 < DEPTH) ? (unsigned char*)(a->ws + WS_HB8) + (size_t)mm * 1024 : nullptr, lane); } }
        }
        SEAM(pb + 10);
    }
#undef IN
#undef SEAM
}

extern "C" void kernel_launch(void* const* d_in, const int* in_sizes, int n_in, void* d_out, int out_size, void* d_ws, size_t ws_size, hipStream_t stream) {
    static int grid = 0;
    if (grid == 0) {
        if (n_in != 26 || out_size != T * 1024 || ws_size < WS_END) { fprintf(stderr, "kernel_launch: unexpected shapes / workspace (n_in %d out %d ws %zu, need %zu)\n", n_in, out_size, ws_size, (size_t)WS_END); grid = -1; return; }
        int dev = 0, cus = 0, per_cu = 0;
        if (hipGetDevice(&dev) != hipSuccess || hipDeviceGetAttribute(&cus, hipDeviceAttributeMultiprocessorCount, dev) != hipSuccess) { grid = -1; return; }
        if (hipFuncSetAttribute((const void*)mega_fwd, hipFuncAttributeMaxDynamicSharedMemorySize, LDS_BYTES) != hipSuccess) { grid = -1; return; }
        if (hipOccupancyMaxActiveBlocksPerMultiprocessor(&per_cu, (const void*)mega_fwd, NWAVES * 64, LDS_BYTES) != hipSuccess || per_cu < 1) { fprintf(stderr, "kernel_launch: occupancy query says %d\n", per_cu); }
        (void)hipGetLastError();
        grid = cus;
    }
    if (grid < 0) return;
    (void)hipMemsetAsync((char*)d_ws + WS_CTL, 0, CTL_ZERO_BYTES, stream);
    Args a{};
    for (int i = 0; i < 26; ++i) a.in[i] = (const float*)d_in[i];
    a.out = (float*)d_out; a.ws = (unsigned char*)d_ws;
#if MK_ONE_LAUNCH
    a.ph_lo = 0; a.ph_hi = NPHASE;
    hipLaunchKernelGGL(mega_fwd, dim3(grid), dim3(NWAVES * 64), LDS_BYTES, stream, a);
#else
    for (int p = 0; p < NPHASE; ++p) { a.ph_lo = p; a.ph_hi = p + 1; hipLaunchKernelGGL(mega_fwd, dim3(grid), dim3(NWAVES * 64), LDS_BYTES, stream, a); }
#endif
}
```
